# Optimizing an MI355X kernel written in HIP

```python
import math
import jax, jax.numpy as jnp
from jax import lax
import numpy as np

D_MODEL = 1024
BATCH = 32
SEQ = 2048
DEPTH = 1

GRID_W = 64
CTX_LEN = 256
MIX_W = D_MODEL
S5_W = MIX_W // 2
S5_H = 16
S5_G = S5_W // S5_H
S5_P = 64
HY_W = MIX_W - S5_W
HY_ORDER = 2
HY_SHORT = 3
HF_BANDS = 16
HF_EMB = 2 * HF_BANDS + 1
HF_HID = 64
HF_INNER = 2
HF_DECAY_SLOW = -math.log(1e-2) / 1.5
HF_DECAY_FAST = -math.log(1e-2) / 0.3
PROJ_W = S5_W + (HY_ORDER + 1) * HY_W
PEER_HEADS = 8
PEER_NKEYS = 128
PEER_EXPERTS = PEER_NKEYS * PEER_NKEYS
PEER_DK = 256
PEER_DK_HALF = PEER_DK // 2
PEER_TOPK = 16
PEER_CHUNK = 128
N_MOD = 6
EPS = 1e-6

kernel_name = "hybrid_s5_hyena_peer_dit_block"


def rmsnorm(x, g):
    xf = x.astype(jnp.float32)
    y = xf * lax.rsqrt(jnp.mean(xf * xf, axis=-1, keepdims=True) + EPS) * g.astype(jnp.float32)
    return y.astype(x.dtype)


def modulate(h, shift, scale):
    return h * (1 + scale) + shift


def short_conv(x, w, b):
    pad = HY_SHORT // 2
    W = x.shape[1]
    xp = jnp.pad(x, ((0, 0), (pad, pad), (0, 0)))
    y = b
    for j in range(HY_SHORT):
        y = y + w[j] * xp[:, j:j + W]
    return y


def s5_discretise(a_re, a_im, log_step, b_re, b_im):
    lam = lax.complex(a_re.astype(jnp.float32), a_im.astype(jnp.float32))
    step = jnp.exp(log_step.astype(jnp.float32))[:, None]
    lam_bar = jnp.exp(lam * step)
    b = lax.complex(b_re.astype(jnp.float32), b_im.astype(jnp.float32))
    b_bar = ((lam_bar - 1.0) / lam)[..., None] * b
    return lam_bar, b_bar


def _linear_combine(e1, e2):
    a1, b1 = e1
    a2, b2 = e2
    return a1 * a2, a2 * b1 + b2


def s5_states(u, lam_bar, b_bar, h0, reverse):
    bu = jnp.einsum('nlgh,gph->nlgp', u.astype(jnp.float32).astype(jnp.complex64), b_bar)
    if reverse:
        bu = jnp.flip(bu, axis=1)
    if h0 is not None:
        bu = bu.at[:, 0].add(lam_bar * h0)
    a = jnp.broadcast_to(lam_bar, (1, bu.shape[1]) + lam_bar.shape)
    _, st = lax.associative_scan(_linear_combine, (a, bu), axis=1)
    if reverse:
        st = jnp.flip(st, axis=1)
    return st


def s5_readout(st, c_re, c_im):
    cc = lax.complex(c_re.astype(jnp.float32), c_im.astype(jnp.float32))
    return jnp.real(jnp.einsum('nlgp,ghp->nlgh', st, cc))


def s5_glu(y, w, b):
    gy = jax.nn.gelu(y)
    return gy * jax.nn.sigmoid(gy @ w.astype(jnp.float32) + b.astype(jnp.float32))


def hyena_filters(L, w1, b1, wh, bh, freq, wout, decay):
    f32 = jnp.float32
    pos = jnp.arange(L, dtype=f32)
    t = pos / max(L - 1, 1)
    bands = jnp.linspace(1e-4, HF_BANDS - 1, HF_BANDS, dtype=f32)
    ang = (2.0 * math.pi / L) * pos[:, None] * bands[None, :]
    feats = jnp.concatenate([t[:, None], jnp.cos(ang), -jnp.sin(ang)], axis=-1)
    fr = freq.astype(f32)
    hid = jnp.sin(fr * (feats @ w1.astype(f32) + b1.astype(f32)))
    for i in range(HF_INNER):
        hid = jnp.sin(fr * (hid @ wh[i].astype(f32) + bh[i].astype(f32)))
    h = (hid @ wout.astype(f32)) * jnp.exp(-t[:, None] * jnp.abs(decay.astype(f32)))
    h = h.reshape(L, HY_ORDER, 2, HY_W)
    return h * lax.rsqrt(jnp.sum(h * h, axis=(0, 2), keepdims=True) + EPS)


def bidir_long_conv(z, h_fwd, h_bwd):
    L, C = h_fwd.shape
    k = jnp.concatenate([h_fwd, jnp.zeros((1, C), jnp.float32), h_bwd[:0:-1]], axis=0)
    zf = jnp.fft.rfft(z.astype(jnp.float32), n=2 * L, axis=1)
    kf = jnp.fft.rfft(k, axis=0)
    return jnp.fft.irfft(zf * kf[None], n=2 * L, axis=1)[:, :L]


def hyena_mixer(p, conv_w, conv_b, filt, d_hy, n_rows):
    N, L, C = p.shape
    q = short_conv(p.reshape(N * n_rows, L // n_rows, C), conv_w, conv_b)
    q = q.reshape(N, L, C).astype(jnp.float32)
    v, x1, x2 = jnp.split(q, HY_ORDER + 1, axis=-1)
    z = v
    for o, gate in enumerate((x1, x2)):
        z = gate * (bidir_long_conv(z, filt[:, o, 0], filt[:, o, 1]) + d_hy[o].astype(jnp.float32) * z)
    return z


def merge_head_groups(y_s5, z_hy, w_glu, b_glu, g_s5, g_hy, w_out, dtype):
    s5_out = s5_glu(y_s5, w_glu, b_glu)
    cat = jnp.concatenate([rmsnorm(s5_out, g_s5), rmsnorm(z_hy, g_hy)], axis=-1)
    return cat.astype(dtype) @ w_out


def peer(h, wq, k1, k2, u_tab, v_tab):
    T, D = h.shape
    f32 = jnp.float32
    k1f = k1.astype(f32)
    k2f = k2.astype(f32)

    def block(hb):
        q = (hb @ wq).astype(f32).reshape(hb.shape[0], PEER_HEADS, 2, PEER_DK_HALF)
        s1 = jnp.einsum('chd,hnd->chn', q[:, :, 0], k1f)
        s2 = jnp.einsum('chd,hnd->chn', q[:, :, 1], k2f)
        v1, i1 = lax.top_k(s1, PEER_TOPK)
        v2, i2 = lax.top_k(s2, PEER_TOPK)
        cand = (v1[..., :, None] + v2[..., None, :]).reshape(v1.shape[:-1] + (PEER_TOPK * PEER_TOPK,))
        sc, ci = lax.top_k(cand, PEER_TOPK)
        e = (jnp.take_along_axis(i1, ci // PEER_TOPK, axis=-1) * PEER_NKEYS
             + jnp.take_along_axis(i2, ci % PEER_TOPK, axis=-1))
        g = jax.nn.softmax(sc, axis=-1)
        act = jax.nn.gelu(jnp.einsum('chkd,cd->chk', jnp.take(u_tab, e, axis=0), hb).astype(f32))
        return jnp.einsum('chk,chkd->cd', (g * act).astype(hb.dtype), jnp.take(v_tab, e, axis=0))

    out = lax.map(block, h.reshape(T // PEER_CHUNK, PEER_CHUNK, D))
    return out.reshape(T, D)


def setup_inputs(seed: int = 0) -> dict:
    key = jax.random.key(seed)
    ks = iter(jax.random.split(key, 64))
    f32 = jnp.float32

    def nrm(shape, s):
        return s * jax.random.normal(next(ks), shape, f32)

    n_idx = jnp.arange(S5_P, dtype=f32)
    return {
        "x": nrm((BATCH, SEQ, D_MODEL), 1.0),
        "c": nrm((BATCH, D_MODEL), 1.0),
        "ctx": nrm((BATCH, CTX_LEN, D_MODEL), 1.0),
        "c_ctx": nrm((D_MODEL,), 1.0),
        "w_ada": nrm((DEPTH, D_MODEL, N_MOD * D_MODEL), 0.5 * D_MODEL ** -0.5),
        "b_ada": nrm((DEPTH, N_MOD * D_MODEL), 0.02),
        "g_norm1": 1.0 + nrm((DEPTH, D_MODEL), 0.02),
        "g_norm2": 1.0 + nrm((DEPTH, D_MODEL), 0.02),
        "w_in": nrm((DEPTH, D_MODEL, PROJ_W), D_MODEL ** -0.5),
        "b_in": nrm((DEPTH, PROJ_W), 0.02),
        "s5_a_re": -0.5 + nrm((DEPTH, 2, S5_G, S5_P), 0.01),
        "s5_a_im": math.pi * n_idx + nrm((DEPTH, 2, S5_G, S5_P), 0.01),
        "s5_log_step": jax.random.uniform(next(ks), (DEPTH, 2, S5_G), f32, math.log(1e-3), math.log(1e-1)),
        "s5_b_re": nrm((DEPTH, 2, S5_G, S5_P, S5_H), (2 * S5_H) ** -0.5),
        "s5_b_im": nrm((DEPTH, 2, S5_G, S5_P, S5_H), (2 * S5_H) ** -0.5),
        "s5_c_re": nrm((DEPTH, 2, S5_G, S5_H, S5_P), 0.5),
        "s5_c_im": nrm((DEPTH, 2, S5_G, S5_H, S5_P), 0.5),
        "s5_d": nrm((DEPTH, S5_W), 1.0),
        "w_glu": nrm((DEPTH, S5_W, S5_W), S5_W ** -0.5),
        "b_glu": nrm((DEPTH, S5_W), 0.02),
        "hy_conv_w": nrm((DEPTH, HY_SHORT, (HY_ORDER + 1) * HY_W), HY_SHORT ** -0.5),
        "hy_conv_b": nrm((DEPTH, (HY_ORDER + 1) * HY_W), 0.02),
        "hf_w1": nrm((DEPTH, HF_EMB, HF_HID), HF_EMB ** -0.5),
        "hf_b1": nrm((DEPTH, HF_HID), 0.02),
        "hf_wh": nrm((DEPTH, HF_INNER, HF_HID, HF_HID), HF_HID ** -0.5),
        "hf_bh": nrm((DEPTH, HF_INNER, HF_HID), 0.02),
        "hf_freq": 1.0 + nrm((DEPTH, HF_HID), 0.01),
        "hf_wout": nrm((DEPTH, HF_HID, HY_ORDER * 2 * HY_W), HF_HID ** -0.5),
        "hf_decay": jnp.tile(jnp.linspace(HF_DECAY_SLOW, HF_DECAY_FAST, HY_W, dtype=f32), HY_ORDER * 2)[None]
                    + nrm((DEPTH, HY_ORDER * 2 * HY_W), 0.1),
        "hy_d": nrm((DEPTH, HY_ORDER, HY_W), 0.1),
        "g_out_s5": 1.0 + nrm((DEPTH, S5_W), 0.02),
        "g_out_hy": 1.0 + nrm((DEPTH, HY_W), 0.02),
        "w_out": nrm((DEPTH, MIX_W, D_MODEL), MIX_W ** -0.5),
        "peer_wq": nrm((DEPTH, D_MODEL, PEER_HEADS * PEER_DK), D_MODEL ** -0.5),
        "peer_k1": nrm((DEPTH, PEER_HEADS, PEER_NKEYS, PEER_DK_HALF), PEER_DK_HALF ** -0.5),
        "peer_k2": nrm((DEPTH, PEER_HEADS, PEER_NKEYS, PEER_DK_HALF), PEER_DK_HALF ** -0.5),
        "peer_u": nrm((DEPTH, PEER_EXPERTS, D_MODEL), D_MODEL ** -0.5),
        "peer_v": nrm((DEPTH, PEER_EXPERTS, D_MODEL), 0.5),
        "g_final": 1.0 + nrm((D_MODEL,), 0.02),
    }


def reference(x, c, ctx, c_ctx, w_ada, b_ada, g_norm1, g_norm2, w_in, b_in,
              s5_a_re, s5_a_im, s5_log_step, s5_b_re, s5_b_im, s5_c_re, s5_c_im, s5_d, w_glu, b_glu,
              hy_conv_w, hy_conv_b, hf_w1, hf_b1, hf_wh, hf_bh, hf_freq, hf_wout, hf_decay, hy_d,
              g_out_s5, g_out_hy, w_out, peer_wq, peer_k1, peer_k2, peer_u, peer_v, g_final):
    B, L, D = x.shape
    Lc = ctx.shape[1]
    rows = L // GRID_W
    dt = x.dtype
    for l in range(DEPTH):
        last = l == DEPTH - 1
        mod_x = (jax.nn.silu(c) @ w_ada[l] + b_ada[l])[:, None, :]
        mod_c = (jax.nn.silu(c_ctx) @ w_ada[l] + b_ada[l])[None, None, :]
        shx1, scx1, gx1, shx2, scx2, gx2 = jnp.split(mod_x, N_MOD, axis=-1)
        shc1, scc1, gc1, shc2, scc2, gc2 = jnp.split(mod_c, N_MOD, axis=-1)

        px = modulate(rmsnorm(x, g_norm1[l]), shx1, scx1) @ w_in[l] + b_in[l]
        pc = modulate(rmsnorm(ctx, g_norm1[l]), shc1, scc1) @ w_in[l] + b_in[l]

        d5 = s5_d[l].astype(jnp.float32).reshape(S5_G, S5_H)
        ux = px[..., :S5_W].astype(jnp.float32).reshape(B, L, S5_G, S5_H)
        uc = pc[..., :S5_W].astype(jnp.float32).reshape(B, Lc, S5_G, S5_H)
        y_x = d5 * ux
        y_c = None if last else d5 * uc
        for dr in range(2):
            lam_bar, b_bar = s5_discretise(s5_a_re[l, dr], s5_a_im[l, dr], s5_log_step[l, dr],
                                           s5_b_re[l, dr], s5_b_im[l, dr])
            st_c = s5_states(uc, lam_bar, b_bar, None, dr == 1)
            h0 = st_c[:, -1] if dr == 0 else st_c[:, 0]
            st_x = s5_states(ux, lam_bar, b_bar, h0, dr == 1)
            y_x = y_x + s5_readout(st_x, s5_c_re[l, dr], s5_c_im[l, dr])
            if y_c is not None:
                y_c = y_c + s5_readout(st_c, s5_c_re[l, dr], s5_c_im[l, dr])

        filt_x = hyena_filters(L, hf_w1[l], hf_b1[l], hf_wh[l], hf_bh[l], hf_freq[l], hf_wout[l], hf_decay[l])
        z_x = hyena_mixer(px[..., S5_W:], hy_conv_w[l], hy_conv_b[l], filt_x, hy_d[l], rows)
        mix_x = merge_head_groups(y_x.reshape(B, L, S5_W), z_x, w_glu[l], b_glu[l],
                                  g_out_s5[l], g_out_hy[l], w_out[l], dt)

        if not last:
            filt_c = hyena_filters(Lc, hf_w1[l], hf_b1[l], hf_wh[l], hf_bh[l], hf_freq[l], hf_wout[l], hf_decay[l])
            z_c = hyena_mixer(pc[..., S5_W:], hy_conv_w[l], hy_conv_b[l], filt_c, hy_d[l], 1)
            mix_c = merge_head_groups(y_c.reshape(B, Lc, S5_W), z_c, w_glu[l], b_glu[l],
                                      g_out_s5[l], g_out_hy[l], w_out[l], dt)
            ctx = ctx + gc1 * mix_c
            hc2 = modulate(rmsnorm(ctx, g_norm2[l]), shc2, scc2)
            ctx = ctx + gc2 * peer(hc2.reshape(B * Lc, D), peer_wq[l], peer_k1[l], peer_k2[l],
                                   peer_u[l], peer_v[l]).reshape(B, Lc, D)

        x = x + gx1 * mix_x
        hx2 = modulate(rmsnorm(x, g_norm2[l]), shx2, scx2)
        x = x + gx2 * peer(hx2.reshape(B * L, D), peer_wq[l], peer_k1[l], peer_k2[l],
                           peer_u[l], peer_v[l]).reshape(B, L, D)
    return rmsnorm(x, g_final)
```

```cpp
#include <hip/hip_runtime.h>
#include <stdint.h>
#include <math.h>

#define DI __device__ __forceinline__
typedef unsigned short bf16_t;

constexpr int NB = 32, SEQ = 2048, DM = 1024, LC = 256;
constexpr int NTOK = NB * SEQ;
constexpr int NCTX = NB * LC;
constexpr int PROJ = 2048;
constexpr int S5W = 512, S5H = 16, S5G = 32, S5P = 64;
constexpr int HYW = 512, HYC3 = 1536;
constexpr int GRIDW = 64;
constexpr int HFB = 16, HFE = 33, HFH = 64;
constexpr int PH = 8, PNK = 128, PDH = 128, PTK = 16;
constexpr float EPSF = 1e-6f;

constexpr size_t MiB = 1u << 20;
constexpr size_t WS_MOD = 1 * MiB;
constexpr size_t WS_LAM = 2 * MiB;
constexpr size_t WS_BB = 3 * MiB;
constexpr size_t WS_HRAW = 4 * MiB;
constexpr size_t WS_G = 20 * MiB;
constexpr size_t WS_R1 = 64 * MiB;
constexpr size_t WS_R2 = 216 * MiB;
constexpr size_t WS_PC = WS_R2 + 256 * MiB;
constexpr size_t WS_R3 = 480 * MiB;
constexpr size_t WS_TKG = WS_R3 + 32 * MiB;
constexpr size_t WS_Z3 = 672 * MiB;
constexpr size_t WS_GY = 736 * MiB;
constexpr size_t WS_S5O = 800 * MiB;

DI float bf2f(bf16_t v) { return __uint_as_float(((unsigned)v) << 16); }
DI bf16_t f2bf(float f) { unsigned u = __float_as_uint(f); return (bf16_t)((u + 0x7fffu + ((u >> 16) & 1u)) >> 16); }
DI float silu_f(float x) { return x / (1.f + expf(-x)); }
DI float sigmoid_f(float x) { return 1.f / (1.f + expf(-x)); }
DI float gelu_f(float x) { const float k = 0.7978845608028654f; return 0.5f * x * (1.f + tanhf(k * (x + 0.044715f * x * x * x))); }
DI float wave_sum(float v) {
#pragma unroll
    for (int o = 1; o < 64; o <<= 1) v += __shfl_xor(v, o);
    return v;
}

__global__ void __launch_bounds__(256) k_mod(const float* c, const float* c_ctx, const float* w_ada, const float* b_ada, float* mod) {
    __shared__ float s[DM];
    const int row = blockIdx.y, col = blockIdx.x * 256 + threadIdx.x;
    const float* cv = row < NB ? c + (size_t)row * DM : c_ctx;
    for (int k = threadIdx.x; k < DM; k += 256) s[k] = silu_f(cv[k]);
    __syncthreads();
    float acc = b_ada[col];
    for (int k = 0; k < DM; ++k) acc += s[k] * w_ada[(size_t)k * (6 * DM) + col];
    mod[(size_t)row * (6 * DM) + col] = acc;
}

__global__ void __launch_bounds__(256) k_normmod(const float* src0, const float* src1, const float* g, const float* mod, bf16_t* out, int nrows, int shift_chunk, int scale_chunk, int pad) {
    const int wave = threadIdx.x >> 6, lane = threadIdx.x & 63;
    const int row = blockIdx.x * 4 + wave;
    if (row >= nrows) return;
    const float* xr; int mrow;
    if (row < NTOK) { xr = src0 + (size_t)row * DM; mrow = row / SEQ; } else { xr = src1 + (size_t)(row - NTOK) * DM; mrow = NB; }
    const float* sh = mod + (size_t)mrow * (6 * DM) + shift_chunk * DM;
    const float* sc = mod + (size_t)mrow * (6 * DM) + scale_chunk * DM;
    float v[16]; float ss = 0.f;
#pragma unroll
    for (int j = 0; j < 4; ++j) {
        const float4 t = *(const float4*)(xr + j * 256 + lane * 4);
        v[j * 4 + 0] = t.x; v[j * 4 + 1] = t.y; v[j * 4 + 2] = t.z; v[j * 4 + 3] = t.w;
        ss += t.x * t.x + t.y * t.y + t.z * t.z + t.w * t.w;
    }
    ss = wave_sum(ss);
    const float rstd = rsqrtf(ss * (1.f / DM) + EPSF);
#pragma unroll
    for (int j = 0; j < 4; ++j) {
        const int c0 = j * 256 + lane * 4;
        bf16_t o[4];
#pragma unroll
        for (int i = 0; i < 4; ++i) { const float y = v[j * 4 + i] * rstd * g[c0 + i]; o[i] = f2bf(y * (1.f + sc[c0 + i]) + sh[c0 + i]); }
        uint2 pk; pk.x = (unsigned)o[0] | ((unsigned)o[1] << 16); pk.y = (unsigned)o[2] | ((unsigned)o[3] << 16);
        *(uint2*)(out + (size_t)row * DM + c0) = pk;
    }
}

struct EpiPx { bf16_t* out; const float* bias; int ldc; int pad; DI void operator()(int r, int c, float a) const { out[(size_t)r * ldc + c] = f2bf(a + bias[c]); } };
struct EpiGlu { bf16_t* out; const bf16_t* gy; const float* bias; DI void operator()(int r, int c, float a) const { const float gyv = bf2f(gy[(size_t)r * S5W + c]); out[(size_t)r * S5W + c] = f2bf(gyv * sigmoid_f(a + bias[c])); } };
struct EpiRes { float* out; const float* x; const float* mod; DI void operator()(int r, int c, float a) const { const int b = r / SEQ; out[(size_t)r * DM + c] = x[(size_t)r * DM + c] + mod[(size_t)b * (6 * DM) + 2 * DM + c] * a; } };
struct EpiQ { bf16_t* out; DI void operator()(int r, int c, float a) const { out[(size_t)r * PROJ + c] = f2bf(a); } };

template <class Epi>
__global__ void __launch_bounds__(256) k_gemm(const bf16_t* A, const float* B, Epi epi, int lda, int ldb, int K, int pad) {
    __shared__ float As[16][68];
    __shared__ float Bs[16][64];
    const int tid = threadIdx.x, tx = tid & 15, ty = tid >> 4;
    const int m0 = blockIdx.y * 64, n0 = blockIdx.x * 64;
    float acc[4][4];
#pragma unroll
    for (int i = 0; i < 4; ++i)
#pragma unroll
        for (int j = 0; j < 4; ++j) acc[i][j] = 0.f;
    const int ar = tid >> 2, ak = (tid & 3) * 4;
    const int bk = tid >> 4, bn = (tid & 15) * 4;
    for (int k0 = 0; k0 < K; k0 += 16) {
        const uint2 av = *(const uint2*)(A + (size_t)(m0 + ar) * lda + k0 + ak);
        const float4 bv = *(const float4*)(B + (size_t)(k0 + bk) * ldb + n0 + bn);
        __syncthreads();
        As[ak + 0][ar] = __uint_as_float(av.x << 16); As[ak + 1][ar] = __uint_as_float(av.x & 0xffff0000u);
        As[ak + 2][ar] = __uint_as_float(av.y << 16); As[ak + 3][ar] = __uint_as_float(av.y & 0xffff0000u);
        *(float4*)&Bs[bk][bn] = bv;
        __syncthreads();
#pragma unroll
        for (int kk = 0; kk < 16; ++kk) {
            const float4 a4 = *(const float4*)&As[kk][ty * 4];
            const float4 b4 = *(const float4*)&Bs[kk][tx * 4];
            const float a[4] = {a4.x, a4.y, a4.z, a4.w}, b[4] = {b4.x, b4.y, b4.z, b4.w};
#pragma unroll
            for (int i = 0; i < 4; ++i)
#pragma unroll
                for (int j = 0; j < 4; ++j) acc[i][j] += a[i] * b[j];
        }
    }
#pragma unroll
    for (int i = 0; i < 4; ++i)
#pragma unroll
        for (int j = 0; j < 4; ++j) epi(m0 + ty * 4 + i, n0 + tx * 4 + j, acc[i][j]);
}

__global__ void __launch_bounds__(64) k_s5prep(const float* a_re, const float* a_im, const float* log_step, const float* b_re, const float* b_im, float* lam, float* bb) {
    const int dg = blockIdx.x, p = threadIdx.x;
    const float ar = a_re[dg * S5P + p], ai = a_im[dg * S5P + p];
    const float step = expf(log_step[dg]);
    const float mag = expf(ar * step);
    const float lr = mag * cosf(ai * step), li = mag * sinf(ai * step);
    lam[(dg * S5P + p) * 2 + 0] = lr; lam[(dg * S5P + p) * 2 + 1] = li;
    const float nr = lr - 1.f, ni = li, den = ar * ar + ai * ai;
    const float fr = (nr * ar + ni * ai) / den, fi = (ni * ar - nr * ai) / den;
    for (int h = 0; h < S5H; ++h) {
        const float br = b_re[(size_t)(dg * S5P + p) * S5H + h], bi = b_im[(size_t)(dg * S5P + p) * S5H + h];
        bb[((size_t)(dg * S5P + p) * S5H + h) * 2 + 0] = fr * br - fi * bi;
        bb[((size_t)(dg * S5P + p) * S5H + h) * 2 + 1] = fr * bi + fi * br;
    }
}

__global__ void __launch_bounds__(64) k_s5scan(const bf16_t* px, const bf16_t* pc, const float* lam, const float* bb, const float* c_re, const float* c_im, const float* s5_d, float* ytmp, bf16_t* gy) {
    const int b = blockIdx.x >> 5, g = blockIdx.x & 31, p = threadIdx.x;
    for (int dr = 0; dr < 2; ++dr) {
        const int dg = dr * S5G + g;
        const float lr = lam[(dg * S5P + p) * 2], li = lam[(dg * S5P + p) * 2 + 1];
        float br[S5H], bi[S5H], cr[S5H], ci[S5H];
#pragma unroll
        for (int h = 0; h < S5H; ++h) {
            br[h] = bb[((size_t)(dg * S5P + p) * S5H + h) * 2]; bi[h] = bb[((size_t)(dg * S5P + p) * S5H + h) * 2 + 1];
            cr[h] = c_re[((size_t)dg * S5H + h) * S5P + p]; ci[h] = c_im[((size_t)dg * S5H + h) * S5P + p];
        }
        const float dv = (p < S5H) ? s5_d[g * S5H + p] : 0.f;
        float sr = 0.f, si = 0.f;
        for (int i = 0; i < LC; ++i) {
            const int t = dr == 0 ? i : LC - 1 - i;
            const bf16_t* up = pc + (size_t)(b * LC + t) * S5W + g * S5H;
            const uint4 u0 = *(const uint4*)up, u1 = *(const uint4*)(up + 8);
            const unsigned uw[8] = {u0.x, u0.y, u0.z, u0.w, u1.x, u1.y, u1.z, u1.w};
            float ur = 0.f, ui = 0.f;
#pragma unroll
            for (int h = 0; h < S5H; ++h) { const float u = (h & 1) ? __uint_as_float(uw[h >> 1] & 0xffff0000u) : __uint_as_float(uw[h >> 1] << 16); ur += br[h] * u; ui += bi[h] * u; }
            const float nr = lr * sr - li * si + ur, ni = lr * si + li * sr + ui;
            sr = nr; si = ni;
        }
        for (int i = 0; i < SEQ; ++i) {
            const int t = dr == 0 ? i : SEQ - 1 - i;
            const size_t tok = (size_t)b * SEQ + t;
            const bf16_t* up = px + tok * PROJ + g * S5H;
            const uint4 u0 = *(const uint4*)up, u1 = *(const uint4*)(up + 8);
            const unsigned uw[8] = {u0.x, u0.y, u0.z, u0.w, u1.x, u1.y, u1.z, u1.w};
            float ur = 0.f, ui = 0.f;
#pragma unroll
            for (int h = 0; h < S5H; ++h) { const float u = (h & 1) ? __uint_as_float(uw[h >> 1] & 0xffff0000u) : __uint_as_float(uw[h >> 1] << 16); ur += br[h] * u; ui += bi[h] * u; }
            const float nr = lr * sr - li * si + ur, ni = lr * si + li * sr + ui;
            sr = nr; si = ni;
            float mine = 0.f;
#pragma unroll
            for (int h = 0; h < S5H; ++h) { const float v = wave_sum(cr[h] * sr - ci[h] * si); if (p == h) mine = v; }
            if (p < S5H) {
                if (dr == 0) { const float u = bf2f(up[p]); ytmp[tok * S5W + g * S5H + p] = dv * u + mine; }
                else { const float y = ytmp[tok * S5W + g * S5H + p] + mine; gy[tok * S5W + g * S5H + p] = f2bf(gelu_f(y)); }
            }
        }
    }
}

__global__ void __launch_bounds__(64) k_filt_mlp(const float* w1, const float* b1, const float* wh, const float* bh, const float* freq, const float* wout, const float* decay, float* hraw) {
    __shared__ float feats[HFE];
    __shared__ float hid[2][HFH];
    const int pos = blockIdx.x, j = threadIdx.x;
    const float t = (float)pos / (float)(SEQ - 1);
    if (j == 0) feats[0] = t;
    if (j < HFB) {
        const float band = 1e-4f + (float)j * ((15.0f - 1e-4f) / 15.0f);
        const float ang = (6.283185307179586f / (float)SEQ) * (float)pos * band;
        feats[1 + j] = cosf(ang); feats[1 + HFB + j] = -sinf(ang);
    }
    __syncthreads();
    const float fr = freq[j];
    float a = b1[j];
    for (int i = 0; i < HFE; ++i) a += feats[i] * w1[i * HFH + j];
    hid[0][j] = sinf(fr * a);
    __syncthreads();
    int cur = 0;
    for (int l = 0; l < 2; ++l) {
        float s = bh[l * HFH + j];
        for (int i = 0; i < HFH; ++i) s += hid[cur][i] * wh[(l * HFH + i) * HFH + j];
        hid[cur ^ 1][j] = sinf(fr * s);
        __syncthreads();
        cur ^= 1;
    }
    for (int col = j; col < 2048; col += 64) {
        float s = 0.f;
        for (int i = 0; i < HFH; ++i) s += hid[cur][i] * wout[i * 2048 + col];
        hraw[(size_t)pos * 2048 + col] = s * expf(-t * fabsf(decay[col]));
    }
}
__global__ void __launch_bounds__(256) k_filt_fin(const float* hraw, float* G) {
    __shared__ float red[4];
    const int o = blockIdx.x >> 9, c = blockIdx.x & 511, tid = threadIdx.x;
    const int colf = o * 1024 + c, colb = o * 1024 + 512 + c;
    float ss = 0.f;
    for (int pos = tid; pos < SEQ; pos += 256) { const float a = hraw[(size_t)pos * 2048 + colf], bq = hraw[(size_t)pos * 2048 + colb]; ss += a * a + bq * bq; }
    ss = wave_sum(ss);
    if ((tid & 63) == 0) red[tid >> 6] = ss;
    __syncthreads();
    const float rn = rsqrtf(red[0] + red[1] + red[2] + red[3] + EPSF);
    float* Gc = G + (size_t)(o * 512 + c) * 4096;
    for (int i = tid; i < 4096; i += 256) {
        const int d = i - 2048;
        float v = 0.f;
        if (d >= 0) v = hraw[(size_t)d * 2048 + colf] * rn; else if (d > -2048) v = hraw[(size_t)(-d) * 2048 + colb] * rn;
        Gc[i] = v;
    }
}

__global__ void __launch_bounds__(256) k_shortconv(const bf16_t* px, const float* cw, const float* cb, bf16_t* qc) {
    __shared__ float tile[64][65];
    const int ct = blockIdx.x, row = blockIdx.y, b = blockIdx.z, tid = threadIdx.x;
    const int ch0 = ct * 64, t0 = row * GRIDW;
    for (int e = tid; e < 64 * 64; e += 256) { const int t = e >> 6, c = e & 63; tile[t][c] = bf2f(px[((size_t)b * SEQ + t0 + t) * PROJ + S5W + ch0 + c]); }
    __syncthreads();
    for (int e = tid; e < 64 * 64; e += 256) {
        const int c = e >> 6, t = e & 63, ch = ch0 + c;
        float y = cb[ch] + cw[HYC3 + ch] * tile[t][c];
        if (t > 0) y += cw[ch] * tile[t - 1][c];
        if (t < 63) y += cw[2 * HYC3 + ch] * tile[t + 1][c];
        qc[((size_t)b * HYC3 + ch) * SEQ + t0 + t] = f2bf(y);
    }
}

__global__ void __launch_bounds__(256) k_longconv(const bf16_t* qc, const float* G, const float* hy_d, bf16_t* z3) {
    __shared__ __attribute__((aligned(16))) float zs[SEQ];
    __shared__ float gs[4096 + 16];
    const int c = blockIdx.x, b = blockIdx.y, tid = threadIdx.x;
    const bf16_t* vrow = qc + ((size_t)b * HYC3 + c) * SEQ;
    for (int i = tid; i < SEQ; i += 256) zs[i] = bf2f(vrow[i]);
    const int t0 = tid * 8;
    for (int o = 0; o < 2; ++o) {
        __syncthreads();
        const float* Gc = G + (size_t)(o * 512 + c) * 4096;
        for (int i = tid; i < 4096; i += 256) gs[i] = Gc[i];
        if (tid < 16) gs[4096 + tid] = 0.f;
        __syncthreads();
        float acc[8];
#pragma unroll
        for (int i = 0; i < 8; ++i) acc[i] = 0.f;
        for (int s0 = 0; s0 < SEQ; s0 += 8) {
            const float4 za = *(const float4*)&zs[s0], zb = *(const float4*)&zs[s0 + 4];
            const float z[8] = {za.x, za.y, za.z, za.w, zb.x, zb.y, zb.z, zb.w};
            const int base = t0 - s0 + 2048 - 7;
            float w[15];
#pragma unroll
            for (int k = 0; k < 15; ++k) w[k] = gs[base + k];
#pragma unroll
            for (int i = 0; i < 8; ++i)
#pragma unroll
                for (int j = 0; j < 8; ++j) acc[i] += w[i - j + 7] * z[j];
        }
        const bf16_t* grow = qc + ((size_t)b * HYC3 + (o + 1) * HYW + c) * SEQ;
        const float dd = hy_d[o * HYW + c];
        float r[8];
#pragma unroll
        for (int i = 0; i < 8; ++i) r[i] = bf2f(grow[t0 + i]) * (acc[i] + dd * zs[t0 + i]);
        __syncthreads();
        if (o == 0) {
#pragma unroll
            for (int i = 0; i < 8; ++i) zs[t0 + i] = r[i];
        } else {
            bf16_t* orow = z3 + ((size_t)b * HYW + c) * SEQ;
#pragma unroll
            for (int i = 0; i < 8; ++i) orow[t0 + i] = f2bf(r[i]);
        }
    }
}

__global__ void __launch_bounds__(256) k_cat_s5(const bf16_t* s5o, const float* g_s5, bf16_t* cat) {
    const int wave = threadIdx.x >> 6, lane = threadIdx.x & 63;
    const size_t row = (size_t)blockIdx.x * 4 + wave;
    float v[8]; float ss = 0.f;
    const uint4 pk = *(const uint4*)(s5o + row * S5W + lane * 8);
    const unsigned w[4] = {pk.x, pk.y, pk.z, pk.w};
#pragma unroll
    for (int i = 0; i < 4; ++i) { v[2 * i] = __uint_as_float(w[i] << 16); v[2 * i + 1] = __uint_as_float(w[i] & 0xffff0000u); ss += v[2 * i] * v[2 * i] + v[2 * i + 1] * v[2 * i + 1]; }
    ss = wave_sum(ss);
    const float rstd = rsqrtf(ss * (1.f / S5W) + EPSF);
#pragma unroll
    for (int i = 0; i < 8; ++i) cat[row * DM + lane * 8 + i] = f2bf(v[i] * rstd * g_s5[lane * 8 + i]);
}
__global__ void __launch_bounds__(256) k_cat_hy(const bf16_t* z3, const float* g_hy, bf16_t* cat) {
    __shared__ bf16_t tile[HYW][34];
    __shared__ float part[8][32];
    __shared__ float rs[32];
    const int tt = blockIdx.x, b = blockIdx.y, tid = threadIdx.x, t0 = tt * 32;
    for (int e = tid; e < HYW * 32; e += 256) { const int c = e >> 5, t = e & 31; tile[c][t] = z3[((size_t)b * HYW + c) * SEQ + t0 + t]; }
    __syncthreads();
    { const int t = tid & 31, q = tid >> 5; float ss = 0.f; for (int c = q * 64; c < q * 64 + 64; ++c) { const float v = bf2f(tile[c][t]); ss += v * v; } part[q][t] = ss; }
    __syncthreads();
    if (tid < 32) { float s = 0.f; for (int qq = 0; qq < 8; ++qq) s += part[qq][tid]; rs[tid] = rsqrtf(s * (1.f / HYW) + EPSF); }
    __syncthreads();
    for (int e = tid; e < HYW * 32; e += 256) { const int t = e >> 9, c = e & 511; cat[((size_t)b * SEQ + t0 + t) * DM + S5W + c] = f2bf(bf2f(tile[c][t]) * rs[t] * g_hy[c]); }
}

__global__ void __launch_bounds__(256) k_topk(const bf16_t* q, const float* k1, const float* k2, int* tke, float* tkg) {
    __shared__ __attribute__((aligned(16))) float qv[PROJ];
    __shared__ float sc[16][PNK];
    __shared__ float tv[16][PTK];
    __shared__ int ti[16][PTK];
    __shared__ float cand[PH][256];
    const size_t tok = blockIdx.x; const int tid = threadIdx.x;
    for (int i = tid; i < PROJ; i += 256) qv[i] = bf2f(q[tok * PROJ + i]);
    __syncthreads();
    for (int e = tid; e < 16 * PNK; e += 256) {
        const int list = e >> 7, n = e & 127, head = list >> 1, half = list & 1;
        const float* kr = (half ? k2 : k1) + ((size_t)head * PNK + n) * PDH;
        const float* qq = qv + list * PDH;
        float s = 0.f;
        for (int d = 0; d < PDH; d += 4) { const float4 kv = *(const float4*)(kr + d); s += qq[d] * kv.x + qq[d + 1] * kv.y + qq[d + 2] * kv.z + qq[d + 3] * kv.w; }
        sc[list][n] = s;
    }
    __syncthreads();
    if (tid < 16) {
        for (int r = 0; r < PTK; ++r) {
            float best = -INFINITY; int bi = 0;
            for (int n = 0; n < PNK; ++n) { const float v = sc[tid][n]; if (v > best) { best = v; bi = n; } }
            tv[tid][r] = best; ti[tid][r] = bi; sc[tid][bi] = -INFINITY;
        }
    }
    __syncthreads();
    for (int e = tid; e < PH * 256; e += 256) { const int h = e >> 8, ab = e & 255; cand[h][ab] = tv[2 * h][ab >> 4] + tv[2 * h + 1][ab & 15]; }
    __syncthreads();
    if (tid < PH) {
        const int h = tid;
        float m = -INFINITY;
        for (int r = 0; r < PTK; ++r) {
            float best = -INFINITY; int bi = 0;
            for (int n = 0; n < 256; ++n) { const float v = cand[h][n]; if (v > best) { best = v; bi = n; } }
            cand[h][bi] = -INFINITY;
            if (r == 0) m = best;
            tke[tok * 128 + h * PTK + r] = ti[2 * h][bi >> 4] * PNK + ti[2 * h + 1][bi & 15];
            sc[h][r] = expf(best - m);
        }
        float den = 0.f;
        for (int r = 0; r < PTK; ++r) den += sc[h][r];
        for (int r = 0; r < PTK; ++r) tkg[tok * 128 + h * PTK + r] = sc[h][r] / den;
    }
}

__global__ void __launch_bounds__(256) k_gather(const bf16_t* hx2, const int* tke, const float* tkg, const float* ut, const float* vt, const float* mod, const float* g_final, float* xio) {
    __shared__ float coef[128];
    __shared__ int eid[128];
    __shared__ float red[4];
    const size_t tok = blockIdx.x; const int tid = threadIdx.x, wave = tid >> 6, lane = tid & 63, b = (int)(tok / SEQ);
    if (tid < 128) eid[tid] = tke[tok * 128 + tid];
    float h[16];
    {
        const uint4 a = *(const uint4*)(hx2 + tok * DM + lane * 16), c = *(const uint4*)(hx2 + tok * DM + lane * 16 + 8);
        const unsigned w[8] = {a.x, a.y, a.z, a.w, c.x, c.y, c.z, c.w};
#pragma unroll
        for (int i = 0; i < 8; ++i) { h[2 * i] = __uint_as_float(w[i] << 16); h[2 * i + 1] = __uint_as_float(w[i] & 0xffff0000u); }
    }
    __syncthreads();
    for (int k = wave * 32; k < wave * 32 + 32; ++k) {
        const float* ur = ut + (size_t)eid[k] * DM + lane * 16;
        float s = 0.f;
#pragma unroll
        for (int i = 0; i < 4; ++i) { const float4 u4 = *(const float4*)(ur + i * 4); s += u4.x * h[i * 4] + u4.y * h[i * 4 + 1] + u4.z * h[i * 4 + 2] + u4.w * h[i * 4 + 3]; }
        s = wave_sum(s);
        if (lane == 0) coef[k] = tkg[tok * 128 + k] * gelu_f(s);
    }
    __syncthreads();
    float4 acc = {0.f, 0.f, 0.f, 0.f};
    for (int k = 0; k < 128; ++k) {
        const float4 v4 = *(const float4*)(vt + (size_t)eid[k] * DM + tid * 4);
        const float cf = coef[k];
        acc.x += cf * v4.x; acc.y += cf * v4.y; acc.z += cf * v4.z; acc.w += cf * v4.w;
    }
    const float* g2 = mod + (size_t)b * (6 * DM) + 5 * DM + tid * 4;
    float4 xv = *(const float4*)(xio + tok * DM + tid * 4);
    xv.x += g2[0] * acc.x; xv.y += g2[1] * acc.y; xv.z += g2[2] * acc.z; xv.w += g2[3] * acc.w;
    float ss = wave_sum(xv.x * xv.x + xv.y * xv.y + xv.z * xv.z + xv.w * xv.w);
    if (lane == 0) red[wave] = ss;
    __syncthreads();
    const float rstd = rsqrtf((red[0] + red[1] + red[2] + red[3]) * (1.f / DM) + EPSF);
    const float* gf = g_final + tid * 4;
    float4 o; o.x = xv.x * rstd * gf[0]; o.y = xv.y * rstd * gf[1]; o.z = xv.z * rstd * gf[2]; o.w = xv.w * rstd * gf[3];
    *(float4*)(xio + tok * DM + tid * 4) = o;
}

extern "C" void kernel_launch(void* const* d_in, const int* in_sizes, int n_in, void* d_out, int out_size, void* d_ws, size_t ws_size, hipStream_t stream) {
    const float* x = (const float*)d_in[0]; const float* c = (const float*)d_in[1]; const float* ctx = (const float*)d_in[2]; const float* c_ctx = (const float*)d_in[3];
    const float* w_ada = (const float*)d_in[4]; const float* b_ada = (const float*)d_in[5]; const float* g_norm1 = (const float*)d_in[6]; const float* g_norm2 = (const float*)d_in[7];
    const float* w_in = (const float*)d_in[8]; const float* b_in = (const float*)d_in[9];
    const float* s5_a_re = (const float*)d_in[10]; const float* s5_a_im = (const float*)d_in[11]; const float* s5_log_step = (const float*)d_in[12];
    const float* s5_b_re = (const float*)d_in[13]; const float* s5_b_im = (const float*)d_in[14]; const float* s5_c_re = (const float*)d_in[15]; const float* s5_c_im = (const float*)d_in[16];
    const float* s5_d = (const float*)d_in[17]; const float* w_glu = (const float*)d_in[18]; const float* b_glu = (const float*)d_in[19];
    const float* hy_conv_w = (const float*)d_in[20]; const float* hy_conv_b = (const float*)d_in[21];
    const float* hf_w1 = (const float*)d_in[22]; const float* hf_b1 = (const float*)d_in[23]; const float* hf_wh = (const float*)d_in[24]; const float* hf_bh = (const float*)d_in[25];
    const float* hf_freq = (const float*)d_in[26]; const float* hf_wout = (const float*)d_in[27]; const float* hf_decay = (const float*)d_in[28]; const float* hy_d = (const float*)d_in[29];
    const float* g_out_s5 = (const float*)d_in[30]; const float* g_out_hy = (const float*)d_in[31]; const float* w_out = (const float*)d_in[32];
    const float* peer_wq = (const float*)d_in[33]; const float* peer_k1 = (const float*)d_in[34]; const float* peer_k2 = (const float*)d_in[35];
    const float* peer_u = (const float*)d_in[36]; const float* peer_v = (const float*)d_in[37]; const float* g_final = (const float*)d_in[38];
    float* out = (float*)d_out;
    unsigned char* ws = (unsigned char*)d_ws;
    float* mod = (float*)(ws + WS_MOD); float* lam = (float*)(ws + WS_LAM); float* bb = (float*)(ws + WS_BB);
    float* hraw = (float*)(ws + WS_HRAW); float* G = (float*)(ws + WS_G);
    bf16_t* h1 = (bf16_t*)(ws + WS_R1); float* ytmp = (float*)(ws + WS_R1); bf16_t* cat = (bf16_t*)(ws + WS_R1); bf16_t* hx2 = (bf16_t*)(ws + WS_R1);
    bf16_t* px = (bf16_t*)(ws + WS_R2); bf16_t* pc = (bf16_t*)(ws + WS_PC); bf16_t* q = (bf16_t*)(ws + WS_R2);
    bf16_t* qc = (bf16_t*)(ws + WS_R3); int* tke = (int*)(ws + WS_R3); float* tkg = (float*)(ws + WS_TKG);
    bf16_t* z3 = (bf16_t*)(ws + WS_Z3); bf16_t* gy = (bf16_t*)(ws + WS_GY); bf16_t* s5o = (bf16_t*)(ws + WS_S5O);

    k_mod<<<dim3(6 * DM / 256, NB + 1), 256, 0, stream>>>(c, c_ctx, w_ada, b_ada, mod);
    k_s5prep<<<2 * S5G, 64, 0, stream>>>(s5_a_re, s5_a_im, s5_log_step, s5_b_re, s5_b_im, lam, bb);
    k_filt_mlp<<<SEQ, 64, 0, stream>>>(hf_w1, hf_b1, hf_wh, hf_bh, hf_freq, hf_wout, hf_decay, hraw);
    k_filt_fin<<<2 * HYW, 256, 0, stream>>>(hraw, G);
    k_normmod<<<(NTOK + NCTX) / 4, 256, 0, stream>>>(x, ctx, g_norm1, mod, h1, NTOK + NCTX, 0, 1, 0);
    k_gemm<EpiPx><<<dim3(PROJ / 64, NTOK / 64), 256, 0, stream>>>(h1, w_in, EpiPx{px, b_in, PROJ, 0}, DM, PROJ, DM, 0);
    k_gemm<EpiPx><<<dim3(S5W / 64, NCTX / 64), 256, 0, stream>>>(h1 + (size_t)NTOK * DM, w_in, EpiPx{pc, b_in, S5W, 0}, DM, PROJ, DM, 0);
    k_s5scan<<<NB * S5G, 64, 0, stream>>>(px, pc, lam, bb, s5_c_re, s5_c_im, s5_d, ytmp, gy);
    k_shortconv<<<dim3(HYC3 / 64, SEQ / GRIDW, NB), 256, 0, stream>>>(px, hy_conv_w, hy_conv_b, qc);
    k_longconv<<<dim3(HYW, NB), 256, 0, stream>>>(qc, G, hy_d, z3);
    k_gemm<EpiGlu><<<dim3(S5W / 64, NTOK / 64), 256, 0, stream>>>(gy, w_glu, EpiGlu{s5o, gy, b_glu}, S5W, S5W, S5W, 0);
    k_cat_s5<<<NTOK / 4, 256, 0, stream>>>(s5o, g_out_s5, cat);
    k_cat_hy<<<dim3(SEQ / 32, NB), 256, 0, stream>>>(z3, g_out_hy, cat);
    k_gemm<EpiRes><<<dim3(DM / 64, NTOK / 64), 256, 0, stream>>>(cat, w_out, EpiRes{out, x, mod}, DM, DM, DM, 0);
    k_normmod<<<NTOK / 4, 256, 0, stream>>>(out, out, g_norm2, mod, hx2, NTOK, 3, 4, 0);
    k_gemm<EpiQ><<<dim3(PROJ / 64, NTOK / 64), 256, 0, stream>>>(hx2, peer_wq, EpiQ{q}, DM, PROJ, DM, 0);
    k_topk<<<NTOK, 256, 0, stream>>>(q, peer_k1, peer_k2, tke, tkg);
    k_gather<<<NTOK, 256, 0, stream>>>(hx2, tke, tkg, peer_u, peer_v, mod, g_final, out);
}
```

```cpp
#include <hip/hip_runtime.h>
#include <stdint.h>
#include <math.h>
#include <stdio.h>

#define DI __device__ __forceinline__
#define LAS __attribute__((address_space(3)))
typedef unsigned short bf16_t;

constexpr int NB = 32, SEQ = 2048, DM = 1024, LC = 256;
constexpr int NTOK = NB * SEQ;
constexpr int NCTX = NB * LC;
constexpr int PROJ = 2048;
constexpr int S5W = 512, S5H = 16, S5G = 32, S5P = 64;
constexpr int HYW = 512, HYC3 = 1536;
constexpr int GRIDW = 64;
constexpr int HFB = 16, HFE = 33, HFH = 64;
constexpr int PH = 8, PNK = 128, PDH = 128, PTK = 16;
constexpr float EPSF = 1e-6f;
constexpr int NT = 512, NWV = 8;

constexpr size_t MiB = 1u << 20;
constexpr size_t WS_CTL = 0, CTL_ZERO_BYTES = 64 * 1024;
constexpr size_t WS_MOD = 1 * MiB;
constexpr size_t WS_LAM = 2 * MiB;
constexpr size_t WS_BB = 3 * MiB;
constexpr size_t WS_HRAW = 4 * MiB;
constexpr size_t WS_G = 20 * MiB;
constexpr size_t WS_WINT = 36 * MiB, WS_WQT = 40 * MiB, WS_WOUTT = 44 * MiB, WS_WGLUT = 46 * MiB;
constexpr size_t WS_KB = 47 * MiB;
constexpr size_t WS_GR = 48 * MiB;
constexpr size_t WS_S5T = 57 * MiB;
constexpr size_t WS_R1 = 64 * MiB;
constexpr size_t WS_R2 = 216 * MiB;
constexpr size_t WS_PC = WS_R2 + 256 * MiB;
constexpr size_t WS_R3 = 480 * MiB;
constexpr size_t WS_TKG = WS_R3 + 32 * MiB;
constexpr size_t WS_TKS = 864 * MiB;
constexpr size_t WS_Z3 = 672 * MiB;
constexpr size_t WS_GY = 736 * MiB;
constexpr size_t WS_S5O = 800 * MiB;
constexpr size_t WS_X1B = 544 * MiB;

constexpr size_t WS_U8 = 864 * MiB, WS_V8 = 880 * MiB;
constexpr size_t WS_SU = 896 * MiB, WS_SV = WS_SU + 65536;

constexpr size_t WS_U4 = 948 * MiB, WS_V4 = 956 * MiB;
constexpr size_t WS_L = 928 * MiB;

constexpr int LDS_BYTES = 163840;
constexpr int MISC_OFF = 163840 - 256;

DI float bf2f(bf16_t v) { return __uint_as_float(((unsigned)v) << 16); }
typedef float f32x2e_t __attribute__((ext_vector_type(2)));
typedef __bf16 bf16x2e_t __attribute__((ext_vector_type(2)));
DI bf16_t f2bf(float f) { return __builtin_bit_cast(bf16_t, (__bf16)f); }
DI unsigned pk2(float lo, float hi) { const f32x2e_t v = {lo, hi}; return __builtin_bit_cast(unsigned, __builtin_convertvector(v, bf16x2e_t)); }
DI float silu_f(float x) { return x / (1.f + expf(-x)); }
DI float sigmoid_f(float x) { return 1.f / (1.f + expf(-x)); }
DI float gelu_f(float x) { const float k = 0.7978845608028654f; return 0.5f * x * (1.f + tanhf(k * (x + 0.044715f * x * x * x))); }
DI float gelu_fast(float x) { const float u = x + 0.044715f * x * x * x; return x * __builtin_amdgcn_rcpf(1.f + __expf(-1.5957691216057308f * u)); }
template <int CTRL> DI float dpp_f(float v) { return __builtin_bit_cast(float, __builtin_amdgcn_update_dpp(0, __builtin_bit_cast(int, v), CTRL, 0xf, 0xf, true)); }
DI float rdlane_f(float v, int l) { return __builtin_bit_cast(float, __builtin_amdgcn_readlane(__builtin_bit_cast(int, v), l)); }
DI float row_sum(float v) { v += dpp_f<0xB1>(v); v += dpp_f<0x4E>(v); v += dpp_f<0x141>(v); v += dpp_f<0x140>(v); return v; }
DI float row_max(float v) { v = fmaxf(v, dpp_f<0xB1>(v)); v = fmaxf(v, dpp_f<0x4E>(v)); v = fmaxf(v, dpp_f<0x141>(v)); v = fmaxf(v, dpp_f<0x140>(v)); return v; }
DI float wave_sum(float v) { v = row_sum(v); return (rdlane_f(v, 0) + rdlane_f(v, 16)) + (rdlane_f(v, 32) + rdlane_f(v, 48)); }
DI float half_sum(float v, int lane) { v = row_sum(v); const float a = rdlane_f(v, 0) + rdlane_f(v, 16), b = rdlane_f(v, 32) + rdlane_f(v, 48); return lane < 32 ? a : b; }
DI float half_max(float v, int lane) { v = row_max(v); const float a = fmaxf(rdlane_f(v, 0), rdlane_f(v, 16)), b = fmaxf(rdlane_f(v, 32), rdlane_f(v, 48)); return lane < 32 ? a : b; }

#define XB_TMO      128
#define XB_XCNT(j)  (256  + 64 * (j))
#define XB_XSUB(j)  (1280 + 64 * (j))
#define XB_XGEN(j)  (2304 + 64 * (j))
#define XB_TOP      3328
#define XB_TOPGEN   3392
#define XCD_BAR_WORDS 3456
#define XB_SPIN_CAP (1u << 25)
DI unsigned xb_ld(unsigned* p)              { return __hip_atomic_load(p, __ATOMIC_RELAXED, __HIP_MEMORY_SCOPE_AGENT); }
DI unsigned xb_add(unsigned* p, unsigned v) { return __hip_atomic_fetch_add(p, v, __ATOMIC_RELAXED, __HIP_MEMORY_SCOPE_AGENT); }
DI unsigned xb_xcc_id() { return (unsigned)__builtin_amdgcn_s_getreg((3 << 11) | 20) & 0xFu; }
#define XB_SPIN(cond, bar) do { unsigned _sp = 0; while (cond) { __builtin_amdgcn_s_sleep(1); \
    if ((++_sp & 255u) == 0u) { if (xb_ld(&(bar)[XB_TMO])) break; if (_sp > XB_SPIN_CAP) { atomicAdd(&(bar)[XB_TMO], 1u); break; } } } } while (0)
struct XcdBarrier { unsigned* bar; unsigned x; volatile LAS unsigned* st; };
DI XcdBarrier xcd_barrier_post(unsigned* bar, volatile LAS unsigned* st) {
    XcdBarrier b; b.bar = bar; b.x = xb_xcc_id(); b.st = st;
    if (threadIdx.x == 0) (void)xb_add(&bar[XB_XCNT(b.x)], 1u);
    return b;
}
DI void xcd_barrier_complete(unsigned* bar, unsigned x, unsigned& nloc, unsigned& nx) {
    const unsigned G = gridDim.x * gridDim.y * gridDim.z;
    unsigned sum, cnt, mine, sp = 0u;
    for (;;) {
        sum = 0u; cnt = 0u; mine = 0u;
#pragma unroll
        for (unsigned j = 0; j < 16; ++j) { const unsigned c = xb_ld(&bar[XB_XCNT(j)]); sum += c; cnt += (c > 0u) ? 1u : 0u; mine = (j == x) ? c : mine; }
        if (sum == G) break;
        __builtin_amdgcn_s_sleep(1);
        if ((++sp & 255u) == 0u) { if (xb_ld(&bar[XB_TMO])) break; if (sp > XB_SPIN_CAP) { atomicAdd(&bar[XB_TMO], 1u); break; } }
    }
    nloc = mine > 0u ? mine : 1u; nx = cnt > 0u ? cnt : 1u;
}
DI void xcd_barrier(const XcdBarrier& b) {
    asm volatile("s_waitcnt vmcnt(0)" ::: "memory");
    __syncthreads();
    if (threadIdx.x == 0) {
        unsigned* bar = b.bar;
        __builtin_amdgcn_s_waitcnt(0);
        unsigned nloc = b.st[0], nx = b.st[1];
        if (nloc == 0u) { xcd_barrier_complete(bar, b.x, nloc, nx); b.st[0] = nloc; b.st[1] = nx; }
        const unsigned old = xb_add(&bar[XB_XSUB(b.x)], 1u);
        const unsigned gen = old / nloc;
        if (old + 1u == (gen + 1u) * nloc) {
            __builtin_amdgcn_fence(__ATOMIC_RELEASE, "agent");
            asm volatile("s_waitcnt vmcnt(0)" ::: "memory");
            const unsigned og = xb_add(&bar[XB_TOP], 1u);
            const unsigned tg = og / nx;
            if (og + 1u == (tg + 1u) * nx) xb_add(&bar[XB_TOPGEN], 1u);
            else XB_SPIN(xb_ld(&bar[XB_TOPGEN]) == tg, bar);
            __builtin_amdgcn_fence(__ATOMIC_ACQUIRE, "agent");
            xb_add(&bar[XB_XGEN(b.x)], 1u);
            asm volatile("s_waitcnt vmcnt(0)" ::: "memory");
        } else {
            XB_SPIN(xb_ld(&bar[XB_XGEN(b.x)]) == gen, bar);
            __builtin_amdgcn_fence(__ATOMIC_ACQUIRE, "agent");
            asm volatile("s_waitcnt vmcnt(0)" ::: "memory");
        }
    }
    __syncthreads();
}

namespace pg8 {
#define PG8_LAS __attribute__((address_space(3)))
typedef unsigned short bf16_t;
typedef short bf16x8 __attribute__((ext_vector_type(8)));
typedef float f32x4 __attribute__((ext_vector_type(4)));
typedef unsigned u32x4 __attribute__((ext_vector_type(4)));
constexpr int BM = 256, BK = 64, HALF = 128, HTB = HALF * BK * 2  , STAGE_BYTES = 8 * HTB, NXCD = 8, WGM = 8;

__host__ __device__ __forceinline__ int lds_byte(int r, int c) { const int st = (r >> 4) * 2 + (c >> 5), rr = r & 15, cc = c & 31, ob = rr * 64 + cc * 2; return st * 1024 + (ob ^ (((ob >> 9) & 1) << 5)); }
__host__ __device__ __forceinline__ void stage_rc(int b, int& R, int& C) { const int st = b / 1024, sb = b % 1024, swz = sb ^ (((sb >> 9) & 1) << 5); R = (st >> 1) * 16 + swz / 64; C = (st & 1) * 32 + (swz % 64) / 2; }
__host__ __device__ __forceinline__ int perm32(int rho) { const int n = rho >> 4, i = rho & 15; return 8 * (i >> 2) + 4 * n + (i & 3); }

struct Unit { int pm, pn; };
struct Gemm { const bf16_t* A; const bf16_t* Bt; int M, N, K; };

struct StaticOrder {
    int nM, nN, nwg, G, c;
    __host__ __device__ void init(int M, int N, int G_, int c_) { nM = M / BM; nN = N / BM; nwg = nM * nN; G = G_; c = c_; }
    __host__ __device__ bool next(int i, Unit& u) const {
        const long L = (long)i * G + c; if (L >= nwg) return false;
        int wgid = (int)L; { const int q = nwg / NXCD, r = nwg % NXCD, xcd = wgid % NXCD, off = wgid / NXCD; wgid = (xcd < r ? xcd * (q + 1) : r * (q + 1) + (xcd - r) * q) + off; }
        const int nig = WGM * nN, gid = wgid / nig, fm = gid * WGM, gsz = (nM - fm) < WGM ? (nM - fm) : WGM;
        u.pm = fm + ((wgid % nig) % gsz); u.pn = (wgid % nig) / gsz; return true;
    }
    __device__ __forceinline__ void a_ready(const Unit&) const {}
    __device__ __forceinline__ void done(const Unit&) const {}
};
__device__ __forceinline__ unsigned cvt_pk_bf16(float lo, float hi) { unsigned r; asm volatile("v_cvt_pk_bf16_f32 %0, %1, %2" : "=v"(r) : "v"(lo), "v"(hi)); return r; }

struct OrderRowPair {
    int G, c;
    __device__ __forceinline__ void init(int G_, int c_) { G = G_; c = c_; }
    __device__ __forceinline__ bool next(int i, Unit& u) const { const int pm = (i >> 1) * G + c; if (pm >= 256) return false; u.pm = pm; u.pn = i & 1; return true; }
    __device__ __forceinline__ void a_ready(const Unit&) const {}
    __device__ __forceinline__ void done(const Unit&) const {}
};
struct OrderRowQuad {
    int G, c;
    __device__ __forceinline__ void init(int G_, int c_) { G = G_; c = c_; }
    __device__ __forceinline__ bool next(int i, Unit& u) const { const int pm = (i >> 2) * G + c; if (pm >= 256) return false; u.pm = pm; u.pn = i & 3; return true; }
    __device__ __forceinline__ void a_ready(const Unit&) const {}
    __device__ __forceinline__ void done(const Unit&) const {}
};
struct OrderPx {
    StaticOrder so; int G, c;
    __device__ __forceinline__ void init(int G_, int c_) { so.init(65536, 2048, G_, c_); G = G_; c = c_; }
    __device__ __forceinline__ bool next(int i, Unit& u) const {
        if (so.next(i, u)) return true;
        const long L = (long)i * G + c - 2048; if (L < 0 || L >= 64) return false;
        u.pm = 256 + (int)(L >> 1); u.pn = (int)(L & 1); return true;
    }
    __device__ __forceinline__ void a_ready(const Unit&) const {}
    __device__ __forceinline__ void done(const Unit&) const {}
};
struct EpiPxB {
    static constexpr bool PERM = true, AFTER_DRAIN = false;
    bf16_t* px; bf16_t* pc; const float* bias;
    __device__ __forceinline__ void operator()(const f32x4 (&acc)[2][2][4][2], const Unit& u, int wr, int wc, int fr, int fq) const {
        const bool isctx = u.pm >= 256;
        bf16_t* base = isctx ? pc : px; const int ldc = isctx ? 512 : 2048; const int prow = isctx ? u.pm - 256 : u.pm;
        const int row0 = prow * BM + wr * 64 + fr, col0 = u.pn * BM + wc * 32 + 8 * fq;
        f32x4 bv[2][2];
#pragma unroll
        for (int bj = 0; bj < 2; ++bj)
#pragma unroll
            for (int n = 0; n < 2; ++n) bv[bj][n] = *(const f32x4*)(bias + col0 + bj * HALF + 4 * n);
#pragma unroll
        for (int ai = 0; ai < 2; ++ai)
#pragma unroll
            for (int m = 0; m < 4; ++m) { bf16_t* rowp = base + (size_t)(row0 + ai * HALF + m * 16) * ldc + col0;
#pragma unroll
                for (int bj = 0; bj < 2; ++bj) { const f32x4 v0 = acc[ai][bj][m][0] + bv[bj][0], v1 = acc[ai][bj][m][1] + bv[bj][1];
                    u32x4 w; w.x = cvt_pk_bf16(v0[0], v0[1]); w.y = cvt_pk_bf16(v0[2], v0[3]); w.z = cvt_pk_bf16(v1[0], v1[1]); w.w = cvt_pk_bf16(v1[2], v1[3]);
                    *(u32x4*)(rowp + bj * HALF) = w; } }
    }
};
struct EpiGluB {
    static constexpr bool PERM = true, AFTER_DRAIN = false;
    bf16_t* out; const bf16_t* gy; const float* bias;
    __device__ __forceinline__ void operator()(const f32x4 (&acc)[2][2][4][2], const Unit& u, int wr, int wc, int fr, int fq) const {
        const int row0 = u.pm * BM + wr * 64 + fr, col0 = u.pn * BM + wc * 32 + 8 * fq;
        f32x4 bv[2][2];
#pragma unroll
        for (int bj = 0; bj < 2; ++bj)
#pragma unroll
            for (int n = 0; n < 2; ++n) bv[bj][n] = *(const f32x4*)(bias + col0 + bj * HALF + 4 * n);
#pragma unroll
        for (int ai = 0; ai < 2; ++ai)
#pragma unroll
            for (int m = 0; m < 4; ++m) { const size_t off = (size_t)(row0 + ai * HALF + m * 16) * 512 + col0;
#pragma unroll
                for (int bj = 0; bj < 2; ++bj) { const f32x4 v0 = acc[ai][bj][m][0] + bv[bj][0], v1 = acc[ai][bj][m][1] + bv[bj][1];
                    const u32x4 g = *(const u32x4*)(gy + off + bj * HALF);
                    float o[8]; const float a[8] = {v0[0], v0[1], v0[2], v0[3], v1[0], v1[1], v1[2], v1[3]}; const unsigned gw[4] = {g.x, g.y, g.z, g.w};
#pragma unroll
                    for (int i = 0; i < 8; ++i) { const float gv = (i & 1) ? __uint_as_float(gw[i >> 1] & 0xffff0000u) : __uint_as_float(gw[i >> 1] << 16); o[i] = gv / (1.f + __expf(-a[i])); }
                    u32x4 w; w.x = cvt_pk_bf16(o[0], o[1]); w.y = cvt_pk_bf16(o[2], o[3]); w.z = cvt_pk_bf16(o[4], o[5]); w.w = cvt_pk_bf16(o[6], o[7]);
                    *(u32x4*)(out + off + bj * HALF) = w; } }
    }
};
struct EpiResB {
    static constexpr bool PERM = true, AFTER_DRAIN = false;
    bf16_t* out; const float* x; const float* gate;
    __device__ __forceinline__ void operator()(const f32x4 (&acc)[2][2][4][2], const Unit& u, int wr, int wc, int fr, int fq) const {
        const int col0 = u.pn * BM + wc * 32 + 8 * fq; const float* gp = gate + (size_t)(u.pm >> 3) * 6144 + col0;
        f32x4 gv[2][2];
#pragma unroll
        for (int bj = 0; bj < 2; ++bj)
#pragma unroll
            for (int n = 0; n < 2; ++n) gv[bj][n] = *(const f32x4*)(gp + bj * HALF + 4 * n);
#pragma unroll
        for (int ai = 0; ai < 2; ++ai)
#pragma unroll
            for (int m = 0; m < 4; ++m) { const size_t off = (size_t)(u.pm * BM + ai * HALF + wr * 64 + m * 16 + fr) * 1024 + col0;
#pragma unroll
                for (int bj = 0; bj < 2; ++bj) { const f32x4 x0 = *(const f32x4*)(x + off + bj * HALF), x1 = *(const f32x4*)(x + off + bj * HALF + 4);
                    const f32x4 v0 = x0 + gv[bj][0] * acc[ai][bj][m][0], v1 = x1 + gv[bj][1] * acc[ai][bj][m][1];
                    u32x4 w; w.x = cvt_pk_bf16(v0[0], v0[1]); w.y = cvt_pk_bf16(v0[2], v0[3]); w.z = cvt_pk_bf16(v1[0], v1[1]); w.w = cvt_pk_bf16(v1[2], v1[3]);
                    *(u32x4*)(out + off + bj * HALF) = w; } }
    }
};
struct EpiQB {
    static constexpr bool PERM = true, AFTER_DRAIN = false;
    bf16_t* out;
    __device__ __forceinline__ void operator()(const f32x4 (&acc)[2][2][4][2], const Unit& u, int wr, int wc, int fr, int fq) const {
        const int row0 = u.pm * BM + wr * 64 + fr, col0 = u.pn * BM + wc * 32 + 8 * fq;
#pragma unroll
        for (int ai = 0; ai < 2; ++ai)
#pragma unroll
            for (int m = 0; m < 4; ++m) { bf16_t* rowp = out + (size_t)(row0 + ai * HALF + m * 16) * 2048 + col0;
#pragma unroll
                for (int bj = 0; bj < 2; ++bj) { const f32x4 v0 = acc[ai][bj][m][0], v1 = acc[ai][bj][m][1];
                    u32x4 w; w.x = cvt_pk_bf16(v0[0], v0[1]); w.y = cvt_pk_bf16(v0[2], v0[3]); w.z = cvt_pk_bf16(v1[0], v1[1]); w.w = cvt_pk_bf16(v1[2], v1[3]);
                    *(u32x4*)(rowp + bj * HALF) = w; } }
    }
};

template <class Epi, class Sched, bool ALIGN_EPI = false, bool SP2 = false>
__device__ __forceinline__ void gemm_phase(PG8_LAS unsigned char* lds, const Gemm g, const Sched& S, const Epi& E) {
    const int tid = threadIdx.x, wid = __builtin_amdgcn_readfirstlane(tid >> 6), lane = tid & 63, wr = wid >> 2, wc = wid & 3, fr = lane & 15, fq = lane >> 4;
    const int K = g.K, nt = K / BK;
    unsigned voffA[2], voffB[2];
#pragma unroll
    for (int i = 0; i < 2; ++i) { int R, C; stage_rc(tid * 16 + i * 8192, R, C); const int Rb = Epi::PERM ? ((R & ~31) + perm32(R & 31)) : R;
        voffA[i] = (unsigned)(R * K + C) * 2u; voffB[i] = (unsigned)(Rb * K + C) * 2u; }
    const size_t kstep = (size_t)(BK * 2);
    const size_t hstep = (size_t)HALF * K * 2;
    const size_t tstep = 2 * hstep;
    const unsigned ldsw = (unsigned)wid * 1024u;
    const int aoff = lds_byte(wr * 64 + fr, fq * 8), boff = lds_byte(wc * 32 + fr, fq * 8);
#define PG8_SA(b, h) (((b) * 2 + (h)) * HTB)
#define PG8_SB(b, h) ((4 + (b) * 2 + (h)) * HTB)
#define PG8_STAGE(bufoff, gbase, voff) do { _Pragma("unroll") for (int _i = 0; _i < 2; ++_i) \
        __builtin_amdgcn_global_load_lds((const unsigned*)((const char*)(gbase) + (voff)[_i]), (PG8_LAS unsigned*)(lds + (bufoff) + ldsw + _i * 8192), 16, 0, 0); } while (0)
#define PG8_LDA(dst, b, h) do { _Pragma("unroll") for (int m = 0; m < 4; ++m) _Pragma("unroll") for (int k = 0; k < 2; ++k) dst[m][k] = *(const PG8_LAS bf16x8*)(lds + PG8_SA(b, h) + aoff + m * 2048 + k * 1024); } while (0)
#define PG8_LDB(dst, b, h) do { _Pragma("unroll") for (int n = 0; n < 2; ++n) _Pragma("unroll") for (int k = 0; k < 2; ++k) dst[n][k] = *(const PG8_LAS bf16x8*)(lds + PG8_SB(b, h) + boff + n * 2048 + k * 1024); } while (0)
#define PG8_MMA(ai, bj, At, Bt) do { __builtin_amdgcn_s_setprio(1); _Pragma("unroll") for (int m = 0; m < 4; ++m) _Pragma("unroll") for (int n = 0; n < 2; ++n) _Pragma("unroll") for (int k = 0; k < 2; ++k) \
        acc[ai][bj][m][n] = __builtin_amdgcn_mfma_f32_16x16x32_bf16(Bt[n][k], At[m][k], acc[ai][bj][m][n], 0, 0, 0); __builtin_amdgcn_s_setprio(0); } while (0)
#define PG8_WAIT_V(n) asm volatile("s_waitcnt vmcnt(" #n ")" ::: "memory")
#define PG8_WAIT_L(n) asm volatile("s_waitcnt lgkmcnt(" #n ")" ::: "memory")
#define PG8_BAR __builtin_amdgcn_s_barrier()
#define PG8_SCHED __builtin_amdgcn_sched_barrier(0)
    Unit cur, nxt; int ui = 0;
    if (!S.next(0, cur)) return;
    f32x4 acc[2][2][4][2];
#pragma unroll
    for (int a = 0; a < 2; ++a)
#pragma unroll
        for (int b = 0; b < 2; ++b)
#pragma unroll
            for (int m = 0; m < 4; ++m)
#pragma unroll
                for (int n = 0; n < 2; ++n) acc[a][b][m][n] = (f32x4){0.f, 0.f, 0.f, 0.f};
    bf16x8 At[4][2], B0[2][2], B1[2][2];
    const char* cA = (const char*)g.A + (size_t)cur.pm * tstep; const char* cB = (const char*)g.Bt + (size_t)cur.pn * tstep;
    S.a_ready(cur);
    if constexpr (SP2) {
        PG8_STAGE(PG8_SB(0, 0), cB, voffB); PG8_STAGE(PG8_SB(0, 1), cB + hstep, voffB); PG8_STAGE(PG8_SA(0, 0), cA, voffA); PG8_STAGE(PG8_SA(0, 1), cA + hstep, voffA);
        if (wr == 1) PG8_BAR;
        PG8_WAIT_V(2); PG8_BAR;
        PG8_STAGE(PG8_SB(1, 0), cB + kstep, voffB); PG8_STAGE(PG8_SA(1, 0), cA + kstep, voffA); PG8_STAGE(PG8_SB(1, 1), cB + hstep + kstep, voffB);
        PG8_WAIT_V(6); PG8_BAR;
    } else {
        PG8_STAGE(PG8_SB(0, 0), cB, voffB); PG8_STAGE(PG8_SA(0, 0), cA, voffA); PG8_STAGE(PG8_SB(0, 1), cB + hstep, voffB); PG8_STAGE(PG8_SA(0, 1), cA + hstep, voffA);
        if (wr == 1) PG8_BAR;
        PG8_WAIT_V(4); PG8_BAR;
        PG8_STAGE(PG8_SB(1, 0), cB + kstep, voffB); PG8_STAGE(PG8_SA(1, 0), cA + kstep, voffA); PG8_STAGE(PG8_SB(1, 1), cB + hstep + kstep, voffB);
        PG8_WAIT_V(6); PG8_BAR;
    }
    for (;;) {
        const bool has_next = S.next(ui + 1, nxt);
        const char* nA = has_next ? (const char*)g.A + (size_t)nxt.pm * tstep : cA; const char* nB = has_next ? (const char*)g.Bt + (size_t)nxt.pn * tstep : cB;
        for (int t = 0; t < nt; t += 2) {
            const bool last = (t == nt - 2);
            const char* a1 = cA + (size_t)(t + 1) * kstep;
            const char* a2 = last ? nA : cA + (size_t)(t + 2) * kstep; const char* b2 = last ? nB : cB + (size_t)(t + 2) * kstep;
            const char* a3 = a2 + kstep; const char* b3 = b2 + kstep;
            if (last && has_next) S.a_ready(nxt);
            if constexpr (SP2) {
            PG8_LDB(B0, 0, 0); PG8_LDB(B1, 0, 1); PG8_SCHED; PG8_LDA(At, 0, 0); PG8_STAGE(PG8_SA(1, 1), a1 + hstep, voffA);
            PG8_WAIT_V(8); PG8_WAIT_L(0); PG8_BAR; PG8_MMA(0, 0, At, B0); PG8_MMA(0, 1, At, B1); PG8_BAR; PG8_SCHED;
            PG8_LDA(At, 0, 1); PG8_STAGE(PG8_SB(0, 0), b2, voffB); PG8_STAGE(PG8_SB(0, 1), b2 + hstep, voffB); PG8_STAGE(PG8_SA(0, 0), a2, voffA);
            PG8_WAIT_V(8); PG8_WAIT_L(0); PG8_BAR; PG8_MMA(1, 0, At, B0); PG8_MMA(1, 1, At, B1); PG8_BAR; PG8_SCHED;
            PG8_LDB(B0, 1, 0); PG8_LDB(B1, 1, 1); PG8_SCHED; PG8_LDA(At, 1, 0); PG8_STAGE(PG8_SA(0, 1), a2 + hstep, voffA);
            PG8_WAIT_V(8); PG8_WAIT_L(0); PG8_BAR; PG8_MMA(0, 0, At, B0); PG8_MMA(0, 1, At, B1); PG8_BAR; PG8_SCHED;
            PG8_LDA(At, 1, 1); PG8_STAGE(PG8_SB(1, 0), b3, voffB); PG8_STAGE(PG8_SB(1, 1), b3 + hstep, voffB); PG8_STAGE(PG8_SA(1, 0), a3, voffA);
            PG8_WAIT_V(8); PG8_WAIT_L(0); PG8_BAR; PG8_MMA(1, 0, At, B0); PG8_MMA(1, 1, At, B1); PG8_BAR; PG8_SCHED;
            } else {
            PG8_LDB(B0, 0, 0); PG8_SCHED; PG8_LDA(At, 0, 0); PG8_STAGE(PG8_SA(1, 1), a1 + hstep, voffA);
            PG8_WAIT_L(8); PG8_BAR; PG8_WAIT_L(0); PG8_MMA(0, 0, At, B0); PG8_BAR; PG8_SCHED;
            PG8_LDB(B1, 0, 1); PG8_STAGE(PG8_SB(0, 0), b2, voffB);
            PG8_BAR; PG8_WAIT_L(0); PG8_MMA(0, 1, At, B1); PG8_BAR;
            PG8_LDA(At, 0, 1); PG8_STAGE(PG8_SA(0, 0), a2, voffA);
            PG8_BAR; PG8_WAIT_L(0); PG8_MMA(1, 0, At, B0); PG8_BAR; PG8_SCHED;
            PG8_STAGE(PG8_SB(0, 1), b2 + hstep, voffB);
            PG8_WAIT_V(6); PG8_BAR; PG8_MMA(1, 1, At, B1); PG8_BAR;
            PG8_LDB(B0, 1, 0); PG8_SCHED; PG8_LDA(At, 1, 0); PG8_STAGE(PG8_SA(0, 1), a2 + hstep, voffA);
            PG8_WAIT_L(8); PG8_BAR; PG8_WAIT_L(0); PG8_MMA(0, 0, At, B0); PG8_BAR; PG8_SCHED;
            PG8_LDB(B1, 1, 1); PG8_STAGE(PG8_SB(1, 0), b3, voffB);
            PG8_BAR; PG8_WAIT_L(0); PG8_MMA(0, 1, At, B1); PG8_BAR;
            PG8_LDA(At, 1, 1); PG8_STAGE(PG8_SA(1, 0), a3, voffA);
            PG8_BAR; PG8_WAIT_L(0); PG8_MMA(1, 0, At, B0); PG8_BAR; PG8_SCHED;
            PG8_STAGE(PG8_SB(1, 1), b3 + hstep, voffB);
            PG8_WAIT_V(6); PG8_BAR; PG8_MMA(1, 1, At, B1); PG8_BAR;
            }
        }
        if constexpr (ALIGN_EPI) { if (wr == 0) PG8_BAR; }
        if constexpr (!Epi::AFTER_DRAIN) { E(acc, cur, wr, wc, fr, fq); S.done(cur); }
        if (!has_next) break;
#pragma unroll
        for (int a = 0; a < 2; ++a)
#pragma unroll
            for (int b = 0; b < 2; ++b)
#pragma unroll
                for (int m = 0; m < 4; ++m)
#pragma unroll
                    for (int n = 0; n < 2; ++n) acc[a][b][m][n] = (f32x4){0.f, 0.f, 0.f, 0.f};
        cur = nxt; cA = nA; cB = nB; ++ui;
        if constexpr (ALIGN_EPI) { if (wr == 1) PG8_BAR; }
    }
    PG8_WAIT_V(0);
    if constexpr (!ALIGN_EPI) { if (wr == 0) PG8_BAR; }
    PG8_BAR;
    if constexpr (Epi::AFTER_DRAIN) { E.fused(acc, cur, wr, wc, fr, fq, lds, wid, lane); S.done(cur); }
#undef PG8_SA
#undef PG8_SB
#undef PG8_STAGE
#undef PG8_LDA
#undef PG8_LDB
#undef PG8_MMA
#undef PG8_WAIT_V
#undef PG8_WAIT_L
#undef PG8_BAR
#undef PG8_SCHED
}
}

struct Args { const float* in[39]; float* out; unsigned char* ws; int ph_lo, ph_hi; };
struct Frame {
    unsigned char* lds;
    int tid, lane, wave, G, bid;
    const Args* a;
};

DI void ph_mod(Frame& F) {
    const int lane = F.lane, wave = F.wave, col = lane & 31, kh = lane >> 5;
    float* sl = (float*)F.lds + wave * (33 * 128);
    for (int it = F.bid; it < 6 * DM / 32; it += F.G) {
        __syncthreads();
#pragma unroll 33
        for (int e = lane; e < 33 * 128; e += 64) { const int row = e >> 7, kk = e & 127; const float* cv = row < NB ? F.a->in[1] + (size_t)row * DM : F.a->in[3]; const float x = cv[wave * 128 + kk]; sl[e] = x * __builtin_amdgcn_rcpf(1.f + __expf(-x)); }
        asm volatile("s_waitcnt lgkmcnt(0)" ::: "memory");
        float acc[33];
#pragma unroll
        for (int r = 0; r < 33; ++r) acc[r] = 0.f;
        const float* wp = F.a->in[4] + (size_t)(wave * 128 + kh * 64) * (6 * DM) + it * 32 + col;
        const float* sp = sl + kh * 64;
#pragma unroll 4
        for (int k4 = 0; k4 < 16; ++k4) {
            const float w0 = wp[(size_t)(4 * k4) * (6 * DM)], w1 = wp[(size_t)(4 * k4 + 1) * (6 * DM)], w2 = wp[(size_t)(4 * k4 + 2) * (6 * DM)], w3 = wp[(size_t)(4 * k4 + 3) * (6 * DM)];
#pragma unroll
            for (int r = 0; r < 33; ++r) { const float4 s4 = *(const float4*)(sp + r * 128 + 4 * k4); acc[r] += s4.x * w0; acc[r] += s4.y * w1; acc[r] += s4.z * w2; acc[r] += s4.w * w3; }
        }
#pragma unroll
        for (int r = 0; r < 33; ++r) acc[r] += __shfl_xor(acc[r], 32);
        asm volatile("s_waitcnt lgkmcnt(0)" ::: "memory");
        if (kh == 0) {
#pragma unroll
            for (int r = 0; r < 33; ++r) sl[r * 32 + col] = acc[r];
        }
        __syncthreads();
        for (int e = F.tid; e < 33 * 32; e += NT) {
            const int r = e >> 5, c = e & 31;
            float t = F.a->in[5][it * 32 + c];
#pragma unroll
            for (int w = 0; w < NWV; ++w) t += ((float*)F.lds)[w * (33 * 128) + r * 32 + c];
            ((float*)(F.a->ws + WS_MOD))[(size_t)r * (6 * DM) + it * 32 + c] = t;
        }
    }
}


DI void transpose_item(const float* W, int K, int N, bf16_t* WT, float* scr, int item, int lane) {
    const int nblk = N / 32, kb = item / nblk, nb = item % nblk, k0 = 64 * kb, n0 = 32 * nb;
#pragma unroll 32
    for (int i = 0; i < 32; ++i) { const int kk = 2 * i + (lane >> 5); scr[kk * 33 + (lane & 31)] = W[(size_t)(k0 + kk) * N + n0 + (lane & 31)]; }
    asm volatile("s_waitcnt lgkmcnt(0)" ::: "memory");
    const int c = lane & 7;
#pragma unroll
    for (int j = 0; j < 4; ++j) { const int n = (lane >> 3) + 8 * j; const float* sp = scr + (8 * c) * 33 + n;
        uint4 o; o.x = pk2(sp[0 * 33], sp[1 * 33]); o.y = pk2(sp[2 * 33], sp[3 * 33]); o.z = pk2(sp[4 * 33], sp[5 * 33]); o.w = pk2(sp[6 * 33], sp[7 * 33]);
        *(uint4*)(WT + (size_t)(n0 + n) * K + k0 + 8 * c) = o; }
    asm volatile("s_waitcnt lgkmcnt(0)" ::: "memory");
}
DI void ph_wprep(Frame& F) {
    float* scr = (float*)(F.lds + F.wave * 16384);
    const int gw = F.bid * NWV + F.wave, NGW = F.G * NWV;
    constexpr int I_IN = (DM / 64) * (PROJ / 32), I_GLU = (S5W / 64) * (S5W / 32), I_OUT = (DM / 64) * (DM / 32), I_Q = (DM / 64) * (PROJ / 32);
    for (int it = gw; it < I_IN + I_GLU + I_OUT + I_Q; it += NGW) {
        int r = it;
        if (r < I_IN) { transpose_item(F.a->in[8], DM, PROJ, (bf16_t*)(F.a->ws + WS_WINT), scr, r, F.lane); continue; } r -= I_IN;
        if (r < I_GLU) { transpose_item(F.a->in[18], S5W, S5W, (bf16_t*)(F.a->ws + WS_WGLUT), scr, r, F.lane); continue; } r -= I_GLU;
        if (r < I_OUT) { transpose_item(F.a->in[32], DM, DM, (bf16_t*)(F.a->ws + WS_WOUTT), scr, r, F.lane); continue; } r -= I_OUT;
        transpose_item(F.a->in[33], DM, PROJ, (bf16_t*)(F.a->ws + WS_WQT), scr, r, F.lane);
    }
}

DI void ph_s5prep(Frame& F) {
    const int gt = F.bid * NT + F.tid;
    if (gt < 2 * S5G * S5P) {
        const int dg = gt >> 6, p = gt & 63;
        const float ar = (F.a->in[10])[dg * S5P + p], ai = (F.a->in[11])[dg * S5P + p];
        const float step = expf((F.a->in[12])[dg]);
        const float mag = expf(ar * step);
        const float lr = mag * cosf(ai * step), li = mag * sinf(ai * step);
        ((float*)(F.a->ws + WS_LAM))[(dg * S5P + p) * 2 + 0] = lr; ((float*)(F.a->ws + WS_LAM))[(dg * S5P + p) * 2 + 1] = li;
        const float nr = lr - 1.f, ni = li, den = ar * ar + ai * ai;
        const float fr = (nr * ar + ni * ai) / den, fi = (ni * ar - nr * ai) / den;
        for (int h = 0; h < S5H; ++h) {
            const float br = (F.a->in[13])[(size_t)(dg * S5P + p) * S5H + h], bi = (F.a->in[14])[(size_t)(dg * S5P + p) * S5H + h];
            ((float*)(F.a->ws + WS_BB))[((size_t)(dg * S5P + p) * S5H + h) * 2 + 0] = fr * br - fi * bi;
            ((float*)(F.a->ws + WS_BB))[((size_t)(dg * S5P + p) * S5H + h) * 2 + 1] = fr * bi + fi * br;
        }
    }
}

DI void ph_filt_mlp(Frame& F) {
    float* feats = (float*)F.lds;
    float* hidA = feats + 64 * 34;
    float* hidB = hidA + 64 * 64;
    float* wl = hidB + 64 * 64;
    float* wst = wl + 64 * 256;
    const int tid = F.tid;
    float* hT = (float*)(F.a->ws + WS_HRAW);
    for (int it = F.bid; it < 32 * 8; it += F.G) {
        const int pb = it >> 3, cs = it & 7, pos0 = pb * 64, col0 = cs * 256;
        __syncthreads();
        for (int e = tid; e < 64 * 33; e += NT) {
            const int p = e / 33, f = e % 33, pos = pos0 + p;
            float v;
            if (f == 0) v = (float)pos / (float)(SEQ - 1);
            else { const int j = (f - 1) & 15; const float band = 1e-4f + (float)j * ((15.0f - 1e-4f) / 15.0f); const float ang = (6.283185307179586f / (float)SEQ) * (float)pos * band; v = f <= 16 ? cosf(ang) : -sinf(ang); }
            feats[p * 34 + f] = v;
        }
#pragma unroll 8
        for (int e = tid; e < 64 * 256; e += NT) { const int i = e >> 8, c = e & 255; wl[e] = F.a->in[27][(size_t)i * 2048 + col0 + c]; }
        for (int e = tid; e < HFE * HFH; e += NT) wst[e] = F.a->in[22][e];
        __syncthreads();
        const int p = tid >> 3, j0 = (tid & 7) * 8;
        {
            float a[8];
#pragma unroll
            for (int j = 0; j < 8; ++j) a[j] = F.a->in[23][j0 + j];
#pragma unroll 3
            for (int i = 0; i < HFE; ++i) { const float x = feats[p * 34 + i]; const float4 w0 = *(const float4*)(wst + i * HFH + j0), w1 = *(const float4*)(wst + i * HFH + j0 + 4);
                a[0] += x * w0.x; a[1] += x * w0.y; a[2] += x * w0.z; a[3] += x * w0.w; a[4] += x * w1.x; a[5] += x * w1.y; a[6] += x * w1.z; a[7] += x * w1.w; }
#pragma unroll
            for (int j = 0; j < 8; ++j) hidA[p * 64 + j0 + j] = sinf(F.a->in[26][j0 + j] * a[j]);
        }
        float* hin = hidA; float* hout = hidB;
        for (int l = 0; l < 2; ++l) {
            __syncthreads();
            for (int e = tid; e < HFH * HFH; e += NT) wst[e] = F.a->in[24][l * HFH * HFH + e];
            __syncthreads();
            float a[8];
#pragma unroll
            for (int j = 0; j < 8; ++j) a[j] = F.a->in[25][l * HFH + j0 + j];
#pragma unroll 4
            for (int i = 0; i < HFH; ++i) { const float x = hin[p * 64 + i]; const float4 w0 = *(const float4*)(wst + i * HFH + j0), w1 = *(const float4*)(wst + i * HFH + j0 + 4);
                a[0] += x * w0.x; a[1] += x * w0.y; a[2] += x * w0.z; a[3] += x * w0.w; a[4] += x * w1.x; a[5] += x * w1.y; a[6] += x * w1.z; a[7] += x * w1.w; }
#pragma unroll
            for (int j = 0; j < 8; ++j) hout[p * 64 + j0 + j] = sinf(F.a->in[26][j0 + j] * a[j]);
            float* t = hin; hin = hout; hout = t;
        }
        __syncthreads();
        {
            const int c = tid & 255, ph = tid >> 8, col = col0 + c;
            float w[64];
#pragma unroll
            for (int i = 0; i < 64; ++i) w[i] = wl[i * 256 + c];
            const float dec = fabsf(F.a->in[28][col]);
            float* op = hT + (size_t)col * SEQ + pos0 + ph * 32;
#pragma unroll 1
            for (int pq = 0; pq < 16; ++pq) {
                float o[2];
#pragma unroll
                for (int pi = 0; pi < 2; ++pi) {
                    const int pp = ph * 32 + pq * 2 + pi;
                    const float4* hp = (const float4*)(hin + pp * 64);
                    float acc = 0.f;
#pragma unroll
                    for (int i4 = 0; i4 < 16; ++i4) { const float4 h4 = hp[i4]; acc += h4.x * w[4 * i4] + h4.y * w[4 * i4 + 1] + h4.z * w[4 * i4 + 2] + h4.w * w[4 * i4 + 3]; }
                    const float t = (float)(pos0 + pp) / (float)(SEQ - 1);
                    o[pi] = acc * expf(-t * dec);
                }
                *(float2*)(op + pq * 2) = make_float2(o[0], o[1]);
            }
        }
    }
}

DI void ph_filt_fin(Frame& F, int wg, int nwg) {
    float* red = (float*)F.lds;
    const float* hT = (const float*)(F.a->ws + WS_HRAW);
    for (int it = wg; it < 2 * HYW; it += nwg) {
        const int o = it >> 9, c = it & 511;
        const float* hf = hT + (size_t)(o * 1024 + c) * SEQ; const float* hb = hT + (size_t)(o * 1024 + 512 + c) * SEQ;
        const float4 a4 = *(const float4*)(hf + F.tid * 4), b4 = *(const float4*)(hb + F.tid * 4);
        float ss = a4.x * a4.x + a4.y * a4.y + a4.z * a4.z + a4.w * a4.w + b4.x * b4.x + b4.y * b4.y + b4.z * b4.z + b4.w * b4.w;
        ss = wave_sum(ss);
        __syncthreads();
        if (F.lane == 0) red[F.wave] = ss;
        __syncthreads();
        float tot = 0.f;
        for (int w = 0; w < NWV; ++w) tot += red[w];
        const float rn = rsqrtf(tot + EPSF);
        bf16_t* GRc = ((bf16_t*)(F.a->ws + WS_GR)) + (size_t)(o * 512 + c) * 4096;
        const float av[4] = {a4.x, a4.y, a4.z, a4.w}, bv[4] = {b4.x, b4.y, b4.z, b4.w};
#pragma unroll
        for (int j = 0; j < 4; ++j) { const int d = 4 * F.tid + j; GRc[2048 - d] = f2bf(av[j] * rn); if (d >= 1) GRc[2048 + d] = f2bf(bv[j] * rn); }
        if (F.tid == 0) GRc[0] = 0;
    }
}

DI void ph_normmod(Frame& F, const float* src0, const float* src1, int nrows, const float* g, int shift_chunk, int scale_chunk, bf16_t* out) {
    const int lane = F.lane;
    for (int ch = F.bid * NWV + F.wave; ch < nrows / 4; ch += F.G * NWV) {
        const int row0 = ch * 4;
        const float* xr; int mrow;
        if (row0 < NTOK) { xr = src0 + (size_t)row0 * DM; mrow = row0 / SEQ; } else { xr = src1 + (size_t)(row0 - NTOK) * DM; mrow = NB; }
        const float* sh = ((float*)(F.a->ws + WS_MOD)) + (size_t)mrow * (6 * DM) + shift_chunk * DM;
        const float* sc = ((float*)(F.a->ws + WS_MOD)) + (size_t)mrow * (6 * DM) + scale_chunk * DM;
        float4 v[4][4];
#pragma unroll
        for (int r = 0; r < 4; ++r)
#pragma unroll
            for (int j = 0; j < 4; ++j) v[r][j] = *(const float4*)(xr + (size_t)r * DM + j * 256 + lane * 4);
        float4 mg[4], ms[4];
#pragma unroll
        for (int j = 0; j < 4; ++j) { const int c0 = j * 256 + lane * 4; const float4 g4 = *(const float4*)(g + c0), s4 = *(const float4*)(sc + c0); ms[j] = *(const float4*)(sh + c0);
            mg[j] = make_float4(g4.x * (1.f + s4.x), g4.y * (1.f + s4.y), g4.z * (1.f + s4.z), g4.w * (1.f + s4.w)); }
#pragma unroll
        for (int r = 0; r < 4; ++r) {
            float ss = 0.f;
#pragma unroll
            for (int j = 0; j < 4; ++j) ss += v[r][j].x * v[r][j].x + v[r][j].y * v[r][j].y + v[r][j].z * v[r][j].z + v[r][j].w * v[r][j].w;
            ss = wave_sum(ss);
            const float rstd = rsqrtf(ss * (1.f / DM) + EPSF);
#pragma unroll
            for (int j = 0; j < 4; ++j) {
                const int c0 = j * 256 + lane * 4;
                uint2 pk; pk.x = pk2(v[r][j].x * rstd * mg[j].x + ms[j].x, v[r][j].y * rstd * mg[j].y + ms[j].y); pk.y = pk2(v[r][j].z * rstd * mg[j].z + ms[j].z, v[r][j].w * rstd * mg[j].w + ms[j].w);
                *(uint2*)(out + (size_t)(row0 + r) * DM + c0) = pk;
            }
        }
    }
}


DI void ph_normmod_b(Frame& F, const bf16_t* src, const float* g, int shift_chunk, int scale_chunk, bf16_t* out, int row_lo, int row_hi) {
    const int lane = F.lane;
    for (int ch = row_lo / 4 + F.wave; ch < row_hi / 4; ch += NWV) {
        const int row0 = ch * 4, mrow = row0 / SEQ;
        const float* sh = ((float*)(F.a->ws + WS_MOD)) + (size_t)mrow * (6 * DM) + shift_chunk * DM + lane * 16;
        const float* sc = ((float*)(F.a->ws + WS_MOD)) + (size_t)mrow * (6 * DM) + scale_chunk * DM + lane * 16;
        uint4 v[4][2];
#pragma unroll
        for (int r = 0; r < 4; ++r) { v[r][0] = *(const uint4*)(src + (size_t)(row0 + r) * DM + lane * 16); v[r][1] = *(const uint4*)(src + (size_t)(row0 + r) * DM + lane * 16 + 8); }
        float mg[16], ms[16];
#pragma unroll
        for (int j = 0; j < 4; ++j) { const float4 g4 = *(const float4*)(g + lane * 16 + 4 * j), s4 = *(const float4*)(sc + 4 * j), h4 = *(const float4*)(sh + 4 * j);
            mg[4 * j] = g4.x * (1.f + s4.x); mg[4 * j + 1] = g4.y * (1.f + s4.y); mg[4 * j + 2] = g4.z * (1.f + s4.z); mg[4 * j + 3] = g4.w * (1.f + s4.w);
            ms[4 * j] = h4.x; ms[4 * j + 1] = h4.y; ms[4 * j + 2] = h4.z; ms[4 * j + 3] = h4.w; }
#pragma unroll
        for (int r = 0; r < 4; ++r) {
            const unsigned w[8] = {v[r][0].x, v[r][0].y, v[r][0].z, v[r][0].w, v[r][1].x, v[r][1].y, v[r][1].z, v[r][1].w};
            float f[16]; float ss = 0.f;
#pragma unroll
            for (int i = 0; i < 8; ++i) { f[2 * i] = __uint_as_float(w[i] << 16); f[2 * i + 1] = __uint_as_float(w[i] & 0xffff0000u); ss += f[2 * i] * f[2 * i] + f[2 * i + 1] * f[2 * i + 1]; }
            ss = wave_sum(ss);
            const float rstd = rsqrtf(ss * (1.f / DM) + EPSF);
            uint4 o0, o1;
            o0.x = pk2(f[0] * rstd * mg[0] + ms[0], f[1] * rstd * mg[1] + ms[1]); o0.y = pk2(f[2] * rstd * mg[2] + ms[2], f[3] * rstd * mg[3] + ms[3]);
            o0.z = pk2(f[4] * rstd * mg[4] + ms[4], f[5] * rstd * mg[5] + ms[5]); o0.w = pk2(f[6] * rstd * mg[6] + ms[6], f[7] * rstd * mg[7] + ms[7]);
            o1.x = pk2(f[8] * rstd * mg[8] + ms[8], f[9] * rstd * mg[9] + ms[9]); o1.y = pk2(f[10] * rstd * mg[10] + ms[10], f[11] * rstd * mg[11] + ms[11]);
            o1.z = pk2(f[12] * rstd * mg[12] + ms[12], f[13] * rstd * mg[13] + ms[13]); o1.w = pk2(f[14] * rstd * mg[14] + ms[14], f[15] * rstd * mg[15] + ms[15]);
            *(uint4*)(out + (size_t)(row0 + r) * DM + lane * 16) = o0; *(uint4*)(out + (size_t)(row0 + r) * DM + lane * 16 + 8) = o1;
        }
    }
}

struct EpiPx { bf16_t* out; const float* bias; int ldc; DI void operator()(int r, int c, float a) const { out[(size_t)r * ldc + c] = f2bf(a + bias[c]); } };
struct EpiGlu { bf16_t* out; const bf16_t* gy; const float* bias; DI void operator()(int r, int c, float a) const { const float gyv = bf2f(gy[(size_t)r * S5W + c]); out[(size_t)r * S5W + c] = f2bf(gyv * sigmoid_f(a + bias[c])); } };
struct EpiRes { float* out; const float* x; const float* mod; DI void operator()(int r, int c, float a) const { const int b = r / SEQ; out[(size_t)r * DM + c] = x[(size_t)r * DM + c] + mod[(size_t)b * (6 * DM) + 2 * DM + c] * a; } };
struct EpiQ { bf16_t* out; DI void operator()(int r, int c, float a) const { out[(size_t)r * PROJ + c] = f2bf(a); } };

template <class Epi>
DI void ph_gemm(Frame& F, const bf16_t* A, int lda, const float* B, int ldb, int M, int N, int K, const Epi& epi, int item0, int nitems_total) {
    float (*As)[132] = (float (*)[132])F.lds;
    float (*Bs)[64] = (float (*)[64])(F.lds + 16 * 132 * 4);
    const int tid = F.tid, tx = tid & 15, ty = tid >> 4;
    const int nn = N / 64, nit = (M / 128) * nn;
    const int ar = tid >> 2, ak = (tid & 3) * 4;
    const int bk = (tid & 255) >> 4, bn = (tid & 15) * 4;
    for (int itg = F.bid; itg < nitems_total; itg += F.G) {
        const int it = itg - item0;
        if (it < 0 || it >= nit) continue;
        const int m0 = (it / nn) * 128, n0 = (it % nn) * 64;
        float acc[4][4];
#pragma unroll
        for (int i = 0; i < 4; ++i)
#pragma unroll
            for (int j = 0; j < 4; ++j) acc[i][j] = 0.f;
        for (int k0 = 0; k0 < K; k0 += 16) {
            const uint2 av = *(const uint2*)(A + (size_t)(m0 + ar) * lda + k0 + ak);
            float4 bv = {0.f, 0.f, 0.f, 0.f};
            if (tid < 256) bv = *(const float4*)(B + (size_t)(k0 + bk) * ldb + n0 + bn);
            __syncthreads();
            As[ak + 0][ar] = __uint_as_float(av.x << 16); As[ak + 1][ar] = __uint_as_float(av.x & 0xffff0000u);
            As[ak + 2][ar] = __uint_as_float(av.y << 16); As[ak + 3][ar] = __uint_as_float(av.y & 0xffff0000u);
            if (tid < 256) *(float4*)&Bs[bk][bn] = bv;
            __syncthreads();
#pragma unroll
            for (int kk = 0; kk < 16; ++kk) {
                const float4 a4 = *(const float4*)&As[kk][ty * 4];
                const float4 b4 = *(const float4*)&Bs[kk][tx * 4];
                const float a[4] = {a4.x, a4.y, a4.z, a4.w}, b[4] = {b4.x, b4.y, b4.z, b4.w};
#pragma unroll
                for (int i = 0; i < 4; ++i)
#pragma unroll
                    for (int j = 0; j < 4; ++j) acc[i][j] += a[i] * b[j];
            }
        }
#pragma unroll
        for (int i = 0; i < 4; ++i)
#pragma unroll
            for (int j = 0; j < 4; ++j) epi(m0 + ty * 4 + i, n0 + tx * 4 + j, acc[i][j]);
        __syncthreads();
    }
}

DI void ph_s5scan(Frame& F) {
    const int p = F.lane;
    if (F.wave < 4) {
        for (int idx = F.bid * 4 + F.wave; idx < NB * S5G; idx += F.G * 4) {
            const int b = idx >> 5, g = idx & 31;
            for (int dr = 0; dr < 2; ++dr) {
                const int dg = dr * S5G + g;
                const float lr = ((float*)(F.a->ws + WS_LAM))[(dg * S5P + p) * 2], li = ((float*)(F.a->ws + WS_LAM))[(dg * S5P + p) * 2 + 1];
                float br[S5H], bi[S5H], cr[S5H], ci[S5H];
#pragma unroll
                for (int h = 0; h < S5H; ++h) {
                    br[h] = ((float*)(F.a->ws + WS_BB))[((size_t)(dg * S5P + p) * S5H + h) * 2]; bi[h] = ((float*)(F.a->ws + WS_BB))[((size_t)(dg * S5P + p) * S5H + h) * 2 + 1];
                    cr[h] = (F.a->in[15])[((size_t)dg * S5H + h) * S5P + p]; ci[h] = (F.a->in[16])[((size_t)dg * S5H + h) * S5P + p];
                }
                const float dv = (p < S5H) ? (F.a->in[17])[g * S5H + p] : 0.f;
                float sr = 0.f, si = 0.f;
                for (int i = 0; i < LC; ++i) {
                    const int t = dr == 0 ? i : LC - 1 - i;
                    const bf16_t* up = ((bf16_t*)(F.a->ws + WS_PC)) + (size_t)(b * LC + t) * S5W + g * S5H;
                    const uint4 u0 = *(const uint4*)up, u1 = *(const uint4*)(up + 8);
                    const unsigned uw[8] = {u0.x, u0.y, u0.z, u0.w, u1.x, u1.y, u1.z, u1.w};
                    float ur = 0.f, ui = 0.f;
#pragma unroll
                    for (int h = 0; h < S5H; ++h) { const float u = (h & 1) ? __uint_as_float(uw[h >> 1] & 0xffff0000u) : __uint_as_float(uw[h >> 1] << 16); ur += br[h] * u; ui += bi[h] * u; }
                    const float nr = lr * sr - li * si + ur, ni = lr * si + li * sr + ui;
                    sr = nr; si = ni;
                }
                for (int i = 0; i < SEQ; ++i) {
                    const int t = dr == 0 ? i : SEQ - 1 - i;
                    const size_t tok = (size_t)b * SEQ + t;
                    const bf16_t* up = ((bf16_t*)(F.a->ws + WS_R2)) + tok * PROJ + g * S5H;
                    const uint4 u0 = *(const uint4*)up, u1 = *(const uint4*)(up + 8);
                    const unsigned uw[8] = {u0.x, u0.y, u0.z, u0.w, u1.x, u1.y, u1.z, u1.w};
                    float ur = 0.f, ui = 0.f;
#pragma unroll
                    for (int h = 0; h < S5H; ++h) { const float u = (h & 1) ? __uint_as_float(uw[h >> 1] & 0xffff0000u) : __uint_as_float(uw[h >> 1] << 16); ur += br[h] * u; ui += bi[h] * u; }
                    const float nr = lr * sr - li * si + ur, ni = lr * si + li * sr + ui;
                    sr = nr; si = ni;
                    float mine = 0.f;
#pragma unroll
                    for (int h = 0; h < S5H; ++h) { const float v = wave_sum(cr[h] * sr - ci[h] * si); if (p == h) mine = v; }
                    if (p < S5H) {
                        if (dr == 0) { const float u = bf2f(up[p]); ((float*)(F.a->ws + WS_R1))[tok * S5W + g * S5H + p] = dv * u + mine; }
                        else { const float y = ((float*)(F.a->ws + WS_R1))[tok * S5W + g * S5H + p] + mine; ((bf16_t*)(F.a->ws + WS_GY))[tok * S5W + g * S5H + p] = f2bf(gelu_f(y)); }
                    }
                }
            }
        }
    }
}

DI void ph_shortconv(Frame& F) {
    unsigned char* tile = F.lds + F.wave * 18432; unsigned char* otile = tile + 9216;
    const int lane = F.lane, lr = lane >> 3, lp = lane & 7;
    const bf16_t* px = (const bf16_t*)(F.a->ws + WS_R2); bf16_t* qc = (bf16_t*)(F.a->ws + WS_R3);
    constexpr int NCT = HYC3 / 64, NIT = NCT * (SEQ / GRIDW) * NB;
    const int gw = F.bid * NWV + F.wave, NGW = F.G * NWV;
    uint4 n0, n1, n2, n3, n4, n5, n6, n7;
    n0 = n1 = n2 = n3 = n4 = n5 = n6 = n7 = make_uint4(0u, 0u, 0u, 0u);
#define SC_FETCH(IT) { const int ct_ = (IT) % NCT, row_ = ((IT) / NCT) % 32, b_ = (IT) / (NCT * 32); \
        const bf16_t* sp = px + ((size_t)b_ * SEQ + row_ * GRIDW + lr) * PROJ + S5W + ct_ * 64 + lp * 8; \
        n0 = *(const uint4*)sp; n1 = *(const uint4*)(sp + (size_t)8 * PROJ); n2 = *(const uint4*)(sp + (size_t)16 * PROJ); n3 = *(const uint4*)(sp + (size_t)24 * PROJ); \
        n4 = *(const uint4*)(sp + (size_t)32 * PROJ); n5 = *(const uint4*)(sp + (size_t)40 * PROJ); n6 = *(const uint4*)(sp + (size_t)48 * PROJ); n7 = *(const uint4*)(sp + (size_t)56 * PROJ); }
    if (gw < NIT) SC_FETCH(gw)
#pragma unroll 1
    for (int it = gw; it < NIT; it += NGW) {
        const int ct = it % NCT, row = (it / NCT) % 32, b = it / (NCT * 32);
        const int ch0 = ct * 64, t0 = row * GRIDW;
        unsigned char* tw = tile + lr * 144 + lp * 16;
        *(uint4*)(tw) = n0; *(uint4*)(tw + 8 * 144) = n1; *(uint4*)(tw + 16 * 144) = n2; *(uint4*)(tw + 24 * 144) = n3;
        *(uint4*)(tw + 32 * 144) = n4; *(uint4*)(tw + 40 * 144) = n5; *(uint4*)(tw + 48 * 144) = n6; *(uint4*)(tw + 56 * 144) = n7;
        if (it + NGW < NIT) SC_FETCH(it + NGW)
        asm volatile("s_waitcnt lgkmcnt(0)" ::: "memory");
        const int ch = ch0 + lane;
        const float w0 = F.a->in[20][ch], w1 = F.a->in[20][HYC3 + ch], w2 = F.a->in[20][2 * HYC3 + ch], bb = F.a->in[21][ch];
        const bf16_t* col = (const bf16_t*)(tile + lane * 2);
        float xm = 0.f, x0 = bf2f(col[0]);
#pragma unroll
        for (int k = 0; k < 8; ++k) {
            float y[8];
#pragma unroll
            for (int j = 0; j < 8; ++j) {
                const int t = 8 * k + j;
                const float xp = t + 1 < 64 ? bf2f(col[(t + 1) * 72]) : 0.f;
                y[j] = bb + w0 * xm + w1 * x0 + w2 * xp;
                xm = x0; x0 = xp;
            }
            *(uint4*)(otile + lane * 144 + k * 16) = make_uint4(pk2(y[0], y[1]), pk2(y[2], y[3]), pk2(y[4], y[5]), pk2(y[6], y[7]));
        }
        asm volatile("s_waitcnt lgkmcnt(0)" ::: "memory");
#pragma unroll
        for (int k = 0; k < 8; ++k) { const int c = 8 * k + lr;
            *(uint4*)(qc + ((size_t)b * HYC3 + ch0 + c) * SEQ + t0 + 8 * lp) = *(const uint4*)(otile + c * 144 + lp * 16); }
    }
#undef SC_FETCH
}

DI void ph_longconv(Frame& F) {
    float* zs = (float*)F.lds;
    float* gs = zs + SEQ;
    const int tid = F.tid;
    const int t0 = tid * 4;
    for (int it = F.bid; it < HYW * NB; it += F.G) {
        const int c = it & 511, b = it >> 9;
        const bf16_t* vrow = ((bf16_t*)(F.a->ws + WS_R3)) + ((size_t)b * HYC3 + c) * SEQ;
        __syncthreads();
        for (int i = tid; i < SEQ; i += NT) zs[i] = bf2f(vrow[i]);
        for (int o = 0; o < 2; ++o) {
            __syncthreads();
            const float* Gc = ((float*)(F.a->ws + WS_G)) + (size_t)(o * 512 + c) * 4096;
            for (int i = tid; i < 4096; i += NT) gs[i] = Gc[i];
            if (tid < 16) gs[4096 + tid] = 0.f;
            __syncthreads();
            float acc[4] = {0.f, 0.f, 0.f, 0.f};
            for (int s0 = 0; s0 < SEQ; s0 += 8) {
                const float4 za = *(const float4*)&zs[s0], zb = *(const float4*)&zs[s0 + 4];
                const float z[8] = {za.x, za.y, za.z, za.w, zb.x, zb.y, zb.z, zb.w};
                const int base = t0 - s0 + 2048 - 7;
                float w[11];
#pragma unroll
                for (int k = 0; k < 11; ++k) w[k] = gs[base + k];
#pragma unroll
                for (int i = 0; i < 4; ++i)
#pragma unroll
                    for (int j = 0; j < 8; ++j) acc[i] += w[i - j + 7] * z[j];
            }
            const bf16_t* grow = ((bf16_t*)(F.a->ws + WS_R3)) + ((size_t)b * HYC3 + (o + 1) * HYW + c) * SEQ;
            const float dd = (F.a->in[29])[o * HYW + c];
            float r[4];
#pragma unroll
            for (int i = 0; i < 4; ++i) r[i] = bf2f(grow[t0 + i]) * (acc[i] + dd * zs[t0 + i]);
            __syncthreads();
            if (o == 0) {
#pragma unroll
                for (int i = 0; i < 4; ++i) zs[t0 + i] = r[i];
            } else {
                bf16_t* orow = ((bf16_t*)(F.a->ws + WS_Z3)) + ((size_t)b * HYW + c) * SEQ;
#pragma unroll
                for (int i = 0; i < 4; ++i) orow[t0 + i] = f2bf(r[i]);
            }
        }
    }
}

DI void ph_cat_s5(Frame& F, int row_lo, int row_hi) {
    const int lane = F.lane;
    const float4 ga = *(const float4*)(F.a->in[30] + lane * 8), gb = *(const float4*)(F.a->in[30] + lane * 8 + 4);
    for (int rowi = row_lo + F.wave; rowi < row_hi; rowi += NWV) {
        const size_t row = rowi;
        float v[8]; float ss = 0.f;
        const uint4 pk = *(const uint4*)(((const bf16_t*)(F.a->ws + WS_S5O)) + row * S5W + lane * 8);
        const unsigned w[4] = {pk.x, pk.y, pk.z, pk.w};
#pragma unroll
        for (int i = 0; i < 4; ++i) { v[2 * i] = __uint_as_float(w[i] << 16); v[2 * i + 1] = __uint_as_float(w[i] & 0xffff0000u); ss += v[2 * i] * v[2 * i] + v[2 * i + 1] * v[2 * i + 1]; }
        ss = wave_sum(ss);
        const float rstd = rsqrtf(ss * (1.f / S5W) + EPSF);
        *(uint4*)(((bf16_t*)(F.a->ws + WS_R1)) + row * DM + lane * 8) = make_uint4(pk2(v[0] * rstd * ga.x, v[1] * rstd * ga.y), pk2(v[2] * rstd * ga.z, v[3] * rstd * ga.w),
                                                                                   pk2(v[4] * rstd * gb.x, v[5] * rstd * gb.y), pk2(v[6] * rstd * gb.z, v[7] * rstd * gb.w));
    }
}
DI void ph_cat_hy(Frame& F, int it_lo, int it_hi, int it_step) {
    unsigned char* tile = F.lds + F.wave * 18432; unsigned char* otile = tile + 9216;
    float* part = (float*)(F.lds + NWV * 18432);
    const int lane = F.lane, lr = lane >> 3, lp = lane & 7, wv = F.wave;
    const bf16_t* z3 = (const bf16_t*)(F.a->ws + WS_Z3); bf16_t* cat = (bf16_t*)(F.a->ws + WS_R1);
    int par = 0;
    for (int it = it_lo; it < it_hi; it += it_step, par ^= 1) {
        const int tt = it & 31, b = it >> 5, t0 = tt * 64;
        const bf16_t* sp = z3 + ((size_t)b * HYW + wv * 64 + lr) * SEQ + t0 + lp * 8;
        const uint4 n0 = *(const uint4*)sp, n1 = *(const uint4*)(sp + (size_t)8 * SEQ), n2 = *(const uint4*)(sp + (size_t)16 * SEQ), n3 = *(const uint4*)(sp + (size_t)24 * SEQ),
                    n4 = *(const uint4*)(sp + (size_t)32 * SEQ), n5 = *(const uint4*)(sp + (size_t)40 * SEQ), n6 = *(const uint4*)(sp + (size_t)48 * SEQ), n7 = *(const uint4*)(sp + (size_t)56 * SEQ);
        unsigned char* tw = tile + lr * 144 + lp * 16;
        *(uint4*)(tw) = n0; *(uint4*)(tw + 8 * 144) = n1; *(uint4*)(tw + 16 * 144) = n2; *(uint4*)(tw + 24 * 144) = n3;
        *(uint4*)(tw + 32 * 144) = n4; *(uint4*)(tw + 40 * 144) = n5; *(uint4*)(tw + 48 * 144) = n6; *(uint4*)(tw + 56 * 144) = n7;
        asm volatile("s_waitcnt lgkmcnt(0)" ::: "memory");
        float v[64]; float ss = 0.f;
        const bf16_t* col = (const bf16_t*)(tile + lane * 2);
#pragma unroll
        for (int c = 0; c < 64; ++c) { v[c] = bf2f(col[c * 72]); ss += v[c] * v[c]; }
        float* pp = part + par * (NWV * 64);
        pp[wv * 64 + lane] = ss;
        __syncthreads();
        float tot = 0.f;
#pragma unroll
        for (int w = 0; w < NWV; ++w) tot += pp[w * 64 + lane];
        const float rstd = rsqrtf(tot * (1.f / HYW) + EPSF);
        const float* gp = F.a->in[31] + wv * 64;
#pragma unroll
        for (int k = 0; k < 8; ++k) {
            const float4 g0 = *(const float4*)(gp + 8 * k), g1 = *(const float4*)(gp + 8 * k + 4);
            *(uint4*)(otile + lane * 144 + k * 16) = make_uint4(pk2(v[8 * k] * rstd * g0.x, v[8 * k + 1] * rstd * g0.y), pk2(v[8 * k + 2] * rstd * g0.z, v[8 * k + 3] * rstd * g0.w),
                                                                pk2(v[8 * k + 4] * rstd * g1.x, v[8 * k + 5] * rstd * g1.y), pk2(v[8 * k + 6] * rstd * g1.z, v[8 * k + 7] * rstd * g1.w));
        }
        asm volatile("s_waitcnt lgkmcnt(0)" ::: "memory");
#pragma unroll
        for (int k = 0; k < 8; ++k) { const int t = 8 * k + lr;
            *(uint4*)(cat + ((size_t)b * SEQ + t0 + t) * DM + S5W + wv * 64 + lp * 8) = *(const uint4*)(otile + t * 144 + lp * 16); }
    }
}

DI void ph_topk(Frame& F) {
    float* qv = (float*)F.lds;
    float (*sc)[PNK] = (float (*)[PNK])(qv + PROJ);
    float (*tv)[PTK] = (float (*)[PTK])(qv + PROJ + 16 * PNK);
    int (*ti)[PTK] = (int (*)[PTK])(qv + PROJ + 16 * PNK + 256);
    float (*cand)[256] = (float (*)[256])(qv + PROJ + 16 * PNK + 512);
    const int tid = F.tid;
    for (int toki = F.bid; toki < NTOK; toki += F.G) {
        const size_t tok = toki;
        __syncthreads();
        for (int i = tid; i < PROJ; i += NT) qv[i] = bf2f(((bf16_t*)(F.a->ws + WS_R2))[tok * PROJ + i]);
        __syncthreads();
        for (int e = tid; e < 16 * PNK; e += NT) {
            const int list = e >> 7, n = e & 127, head = list >> 1, half = list & 1;
            const float* kr = (half ? (F.a->in[35]) : (F.a->in[34])) + ((size_t)head * PNK + n) * PDH;
            const float* qq = qv + list * PDH;
            float s = 0.f;
            for (int d = 0; d < PDH; d += 4) { const float4 kv = *(const float4*)(kr + d); s += qq[d] * kv.x + qq[d + 1] * kv.y + qq[d + 2] * kv.z + qq[d + 3] * kv.w; }
            sc[list][n] = s;
        }
        __syncthreads();
        if (tid < 16) {
            for (int r = 0; r < PTK; ++r) {
                float best = -INFINITY; int bi = 0;
                for (int n = 0; n < PNK; ++n) { const float v = sc[tid][n]; if (v > best) { best = v; bi = n; } }
                tv[tid][r] = best; ti[tid][r] = bi; sc[tid][bi] = -INFINITY;
            }
        }
        __syncthreads();
        for (int e = tid; e < PH * 256; e += NT) { const int h = e >> 8, ab = e & 255; cand[h][ab] = tv[2 * h][ab >> 4] + tv[2 * h + 1][ab & 15]; }
        __syncthreads();
        if (tid < PH) {
            const int h = tid;
            float m = -INFINITY;
            for (int r = 0; r < PTK; ++r) {
                float best = -INFINITY; int bi = 0;
                for (int n = 0; n < 256; ++n) { const float v = cand[h][n]; if (v > best) { best = v; bi = n; } }
                cand[h][bi] = -INFINITY;
                if (r == 0) m = best;
                ((int*)(F.a->ws + WS_R3))[tok * 128 + h * PTK + r] = ti[2 * h][bi >> 4] * PNK + ti[2 * h + 1][bi & 15];
                sc[h][r] = expf(best - m);
            }
            float den = 0.f;
            for (int r = 0; r < PTK; ++r) den += sc[h][r];
            for (int r = 0; r < PTK; ++r) ((float*)(F.a->ws + WS_TKG))[tok * 128 + h * PTK + r] = sc[h][r] / den;
        }
    }
}

DI void ph_gather(Frame& F) {
    float* coef = (float*)F.lds;
    int* eid = (int*)(coef + 128);
    float* red = coef + 256;
    const int tid = F.tid, wave = F.wave, lane = F.lane;
    for (int toki = F.bid; toki < NTOK; toki += F.G) {
        const size_t tok = toki; const int b = toki / SEQ;
        __syncthreads();
        if (tid < 128) eid[tid] = ((int*)(F.a->ws + WS_R3))[tok * 128 + tid];
        float h[16];
        {
            const uint4 a = *(const uint4*)(((bf16_t*)(F.a->ws + WS_R1)) + tok * DM + lane * 16), c = *(const uint4*)(((bf16_t*)(F.a->ws + WS_R1)) + tok * DM + lane * 16 + 8);
            const unsigned w[8] = {a.x, a.y, a.z, a.w, c.x, c.y, c.z, c.w};
#pragma unroll
            for (int i = 0; i < 8; ++i) { h[2 * i] = __uint_as_float(w[i] << 16); h[2 * i + 1] = __uint_as_float(w[i] & 0xffff0000u); }
        }
        __syncthreads();
        for (int k = wave * 16; k < wave * 16 + 16; ++k) {
            const float* ur = (F.a->in[36]) + (size_t)eid[k] * DM + lane * 16;
            float s = 0.f;
#pragma unroll
            for (int i = 0; i < 4; ++i) { const float4 u4 = *(const float4*)(ur + i * 4); s += u4.x * h[i * 4] + u4.y * h[i * 4 + 1] + u4.z * h[i * 4 + 2] + u4.w * h[i * 4 + 3]; }
            s = wave_sum(s);
            if (lane == 0) coef[k] = ((float*)(F.a->ws + WS_TKG))[tok * 128 + k] * gelu_f(s);
        }
        __syncthreads();
        float2 acc = {0.f, 0.f};
        for (int k = 0; k < 128; ++k) {
            const float2 v2 = *(const float2*)((F.a->in[37]) + (size_t)eid[k] * DM + tid * 2);
            const float cf = coef[k];
            acc.x += cf * v2.x; acc.y += cf * v2.y;
        }
        const float* g2 = ((float*)(F.a->ws + WS_MOD)) + (size_t)b * (6 * DM) + 5 * DM + tid * 2;
        float2 xv = *(const float2*)((F.a->out) + tok * DM + tid * 2);
        xv.x += g2[0] * acc.x; xv.y += g2[1] * acc.y;
        const float ss = wave_sum(xv.x * xv.x + xv.y * xv.y);
        if (lane == 0) red[wave] = ss;
        __syncthreads();
        float tot = 0.f;
        for (int w = 0; w < NWV; ++w) tot += red[w];
        const float rstd = rsqrtf(tot * (1.f / DM) + EPSF);
        const float* gf = (F.a->in[38]) + tid * 2;
        float2 o; o.x = xv.x * rstd * gf[0]; o.y = xv.y * rstd * gf[1];
        *(float2*)((F.a->out) + tok * DM + tid * 2) = o;
    }
}


typedef float f32x2_t __attribute__((ext_vector_type(2)));
typedef _Float16 h2_t __attribute__((ext_vector_type(2)));
DI void ph_tabprep(Frame& F) {
    const int lane = F.lane;
    for (int r = F.bid * NWV + F.wave; r < 2 * 16384; r += F.G * NWV) {
        const int tab = r >> 14, row = r & 16383;
        const float* src = (tab ? F.a->in[37] : F.a->in[36]) + (size_t)row * DM + lane * 16;
        float v[16];
#pragma unroll
        for (int j = 0; j < 4; ++j) { const float4 t = *(const float4*)(src + 4 * j); v[4 * j] = t.x; v[4 * j + 1] = t.y; v[4 * j + 2] = t.z; v[4 * j + 3] = t.w; }
        float m = 0.f;
#pragma unroll
        for (int j = 0; j < 16; ++j) m = fmaxf(m, fabsf(v[j]));
#pragma unroll
        for (int o = 1; o < 64; o <<= 1) m = fmaxf(m, __shfl_xor(m, o));
        const float sc = m > 0.f ? m * (1.f / 440.f) : 1.f, inv = 1.f / sc;
        uint4 o4; int w;
        w = __builtin_amdgcn_cvt_pk_fp8_f32(v[0] * inv, v[1] * inv, 0, false); w = __builtin_amdgcn_cvt_pk_fp8_f32(v[2] * inv, v[3] * inv, w, true); o4.x = (unsigned)w;
        w = __builtin_amdgcn_cvt_pk_fp8_f32(v[4] * inv, v[5] * inv, 0, false); w = __builtin_amdgcn_cvt_pk_fp8_f32(v[6] * inv, v[7] * inv, w, true); o4.y = (unsigned)w;
        w = __builtin_amdgcn_cvt_pk_fp8_f32(v[8] * inv, v[9] * inv, 0, false); w = __builtin_amdgcn_cvt_pk_fp8_f32(v[10] * inv, v[11] * inv, w, true); o4.z = (unsigned)w;
        w = __builtin_amdgcn_cvt_pk_fp8_f32(v[12] * inv, v[13] * inv, 0, false); w = __builtin_amdgcn_cvt_pk_fp8_f32(v[14] * inv, v[15] * inv, w, true); o4.w = (unsigned)w;
        *(uint4*)(F.a->ws + (tab ? WS_V8 : WS_U8) + (size_t)row * DM + lane * 16) = o4;
        if (lane == 0) ((float*)(F.a->ws + (tab ? WS_SV : WS_SU)))[row] = sc;
    }
}

DI void dec16(const uint4& r, float (&f)[16]) {
    const int w[4] = {(int)r.x, (int)r.y, (int)r.z, (int)r.w};
#pragma unroll
    for (int i = 0; i < 4; ++i) { const f32x2_t a = __builtin_amdgcn_cvt_pk_f32_fp8(w[i], false), b = __builtin_amdgcn_cvt_pk_f32_fp8(w[i], true); f[4 * i] = a.x; f[4 * i + 1] = a.y; f[4 * i + 2] = b.x; f[4 * i + 3] = b.y; }
}
DI float dot16(const uint4& r, const f32x2_t (&h2)[8]) {
    const int w[4] = {(int)r.x, (int)r.y, (int)r.z, (int)r.w};
    f32x2_t s2 = {0.f, 0.f};
#pragma unroll
    for (int i = 0; i < 4; ++i) { s2 += __builtin_amdgcn_cvt_pk_f32_fp8(w[i], false) * h2[2 * i]; s2 += __builtin_amdgcn_cvt_pk_f32_fp8(w[i], true) * h2[2 * i + 1]; }
    return s2.x + s2.y;
}
DI void axpy16(const uint4& r, float c, f32x2_t (&acc2)[8]) {
    const int w[4] = {(int)r.x, (int)r.y, (int)r.z, (int)r.w};
    const f32x2_t c2 = {c, c};
#pragma unroll
    for (int i = 0; i < 4; ++i) { acc2[2 * i] += c2 * __builtin_amdgcn_cvt_pk_f32_fp8(w[i], false); acc2[2 * i + 1] += c2 * __builtin_amdgcn_cvt_pk_f32_fp8(w[i], true); }
}
DI float reduce16(const float (&v)[16], int lane) {
    const bool b5 = (lane & 32) != 0, b4 = (lane & 16) != 0, b3 = (lane & 8) != 0, b2 = (lane & 4) != 0;
    float a[8], b[4], c[2];
#pragma unroll
    for (int j = 0; j < 8; ++j) { const float send = b5 ? v[j] : v[j + 8], keep = b5 ? v[j + 8] : v[j]; a[j] = keep + __shfl_xor(send, 32); }
#pragma unroll
    for (int j = 0; j < 4; ++j) { const float send = b4 ? a[j] : a[j + 4], keep = b4 ? a[j + 4] : a[j]; b[j] = keep + __shfl_xor(send, 16); }
#pragma unroll
    for (int j = 0; j < 2; ++j) { const float send = b3 ? b[j] : b[j + 2], keep = b3 ? b[j + 2] : b[j]; c[j] = keep + __shfl_xor(send, 8); }
    const float send = b2 ? c[0] : c[1], keep = b2 ? c[1] : c[0];
    float x = keep + __shfl_xor(send, 4);
    x += __shfl_xor(x, 1); x += __shfl_xor(x, 2);
    return x;
}
DI void ph_gather8(Frame& F) {
    const int lane = F.lane;
    const unsigned char* u8 = F.a->ws + WS_U8 + lane * 16;
    const unsigned char* v8 = F.a->ws + WS_V8 + lane * 16;
    const float* su = (const float*)(F.a->ws + WS_SU); const float* sv = (const float*)(F.a->ws + WS_SV);
    const int* tke = (const int*)(F.a->ws + WS_R3); const float* tkg = (const float*)(F.a->ws + WS_TKG);
    const bf16_t* hx2 = (const bf16_t*)(F.a->ws + WS_R1);
    for (int toki = F.bid * NWV + F.wave; toki < NTOK; toki += F.G * NWV) {
        const size_t tok = toki; const int b = toki / SEQ;
        int ev[2]; float cv[2];
        f32x2_t h2[8];
        {
            const uint4 a = *(const uint4*)(hx2 + tok * DM + lane * 16), c = *(const uint4*)(hx2 + tok * DM + lane * 16 + 8);
            const unsigned w[8] = {a.x, a.y, a.z, a.w, c.x, c.y, c.z, c.w};
#pragma unroll
            for (int i = 0; i < 8; ++i) { h2[i].x = __uint_as_float(w[i] << 16); h2[i].y = __uint_as_float(w[i] & 0xffff0000u); }
        }
#pragma unroll
        for (int half = 0; half < 2; ++half) {
            ev[half] = tke[tok * 128 + half * 64 + lane];
            const float gvv = tkg[tok * 128 + half * 64 + lane];
            const float sue = su[ev[half]], sve = sv[ev[half]];
            float cvh = 0.f;
            uint4 bufA[8], bufB[8];
#pragma unroll
            for (int kk = 0; kk < 8; ++kk) { const int e = __builtin_amdgcn_readlane(ev[half], kk); bufA[kk] = *(const uint4*)(u8 + (size_t)e * DM); }
#pragma unroll 1
            for (int bb = 0; bb < 4; ++bb) {
                float part[16];
#pragma unroll
                for (int kk = 0; kk < 8; ++kk) { const int e = __builtin_amdgcn_readlane(ev[half], bb * 16 + 8 + kk); bufB[kk] = *(const uint4*)(u8 + (size_t)e * DM); }
#pragma unroll
                for (int kk = 0; kk < 8; ++kk) part[kk] = dot16(bufA[kk], h2);
                if (bb < 3) {
#pragma unroll
                    for (int kk = 0; kk < 8; ++kk) { const int e = __builtin_amdgcn_readlane(ev[half], bb * 16 + 16 + kk); bufA[kk] = *(const uint4*)(u8 + (size_t)e * DM); }
                }
#pragma unroll
                for (int kk = 0; kk < 8; ++kk) part[8 + kk] = dot16(bufB[kk], h2);
                const float t2 = __shfl(reduce16(part, lane), (lane & 15) << 2);
                const float c = gvv * gelu_f(t2 * sue) * sve;
                cvh = ((lane >> 4) == bb) ? c : cvh;
            }
            cv[half] = cvh;
        }
        f32x2_t acc2[8];
#pragma unroll
        for (int j = 0; j < 8; ++j) acc2[j] = (f32x2_t){0.f, 0.f};
#pragma unroll
        for (int half = 0; half < 2; ++half) {
            uint4 bufA[8], bufB[8];
#pragma unroll
            for (int kk = 0; kk < 8; ++kk) { const int e = __builtin_amdgcn_readlane(ev[half], kk); bufA[kk] = *(const uint4*)(v8 + (size_t)e * DM); }
#pragma unroll 1
            for (int bb = 0; bb < 4; ++bb) {
#pragma unroll
                for (int kk = 0; kk < 8; ++kk) { const int e = __builtin_amdgcn_readlane(ev[half], bb * 16 + 8 + kk); bufB[kk] = *(const uint4*)(v8 + (size_t)e * DM); }
#pragma unroll
                for (int kk = 0; kk < 8; ++kk) { const float c = __builtin_bit_cast(float, __builtin_amdgcn_readlane(__builtin_bit_cast(int, cv[half]), bb * 16 + kk)); axpy16(bufA[kk], c, acc2); }
                if (bb < 3) {
#pragma unroll
                    for (int kk = 0; kk < 8; ++kk) { const int e = __builtin_amdgcn_readlane(ev[half], bb * 16 + 16 + kk); bufA[kk] = *(const uint4*)(v8 + (size_t)e * DM); }
                }
#pragma unroll
                for (int kk = 0; kk < 8; ++kk) { const float c = __builtin_bit_cast(float, __builtin_amdgcn_readlane(__builtin_bit_cast(int, cv[half]), bb * 16 + 8 + kk)); axpy16(bufB[kk], c, acc2); }
            }
        }
        const float* g2 = (const float*)(F.a->ws + WS_MOD) + (size_t)b * (6 * DM) + 5 * DM + lane * 16;
        float* xr = F.a->out + tok * DM + lane * 16;
        const float* gf = F.a->in[38] + lane * 16;
        float acc[16];
#pragma unroll
        for (int j = 0; j < 8; ++j) { acc[2 * j] = acc2[j].x; acc[2 * j + 1] = acc2[j].y; }
        float xv[16]; float ss = 0.f;
#pragma unroll
        for (int j = 0; j < 4; ++j) {
            const float4 x4 = *(const float4*)(xr + 4 * j), g4 = *(const float4*)(g2 + 4 * j);
            xv[4 * j] = x4.x + g4.x * acc[4 * j]; xv[4 * j + 1] = x4.y + g4.y * acc[4 * j + 1]; xv[4 * j + 2] = x4.z + g4.z * acc[4 * j + 2]; xv[4 * j + 3] = x4.w + g4.w * acc[4 * j + 3];
            ss += xv[4 * j] * xv[4 * j] + xv[4 * j + 1] * xv[4 * j + 1] + xv[4 * j + 2] * xv[4 * j + 2] + xv[4 * j + 3] * xv[4 * j + 3];
        }
        ss = wave_sum(ss);
        const float rstd = rsqrtf(ss * (1.f / DM) + EPSF);
#pragma unroll
        for (int j = 0; j < 4; ++j) {
            const float4 f4 = *(const float4*)(gf + 4 * j);
            float4 o; o.x = xv[4 * j] * rstd * f4.x; o.y = xv[4 * j + 1] * rstd * f4.y; o.z = xv[4 * j + 2] * rstd * f4.z; o.w = xv[4 * j + 3] * rstd * f4.w;
            *(float4*)(xr + 4 * j) = o;
        }
    }
}


DI void ph_keyprep(Frame& F) {
    bf16_t* kb = (bf16_t*)(F.a->ws + WS_KB);
    for (int i = F.bid * NT + F.tid; i < 16 * PNK * PDH; i += F.G * NT) {
        const int list = i >> 14, rem = i & 16383, head = list >> 1;
        kb[i] = f2bf(((list & 1) ? F.a->in[35] : F.a->in[34])[(size_t)head * (PNK * PDH) + rem]);
    }
}

typedef short bf16x8_t __attribute__((ext_vector_type(8)));
typedef float f32x16_t __attribute__((ext_vector_type(16)));
DI void ce_desc(float& x, float& y) { float hi, lo; asm("v_max_f32 %0, %1, %2" : "=v"(hi) : "v"(x), "v"(y)); asm("v_min_f32 %0, %1, %2" : "=v"(lo) : "v"(x), "v"(y)); x = hi; y = lo; }
DI float fmax_raw(float x, float y) { float hi; asm("v_max_f32 %0, %1, %2" : "=v"(hi) : "v"(x), "v"(y)); return hi; }
DI void sort16_desc(float (&a)[16]) {
#define CE(i, j) ce_desc(a[i], a[j]);
    CE(0,1) CE(2,3) CE(0,2) CE(1,3) CE(1,2) CE(4,5) CE(6,7) CE(4,6) CE(5,7) CE(5,6) CE(0,4) CE(2,6) CE(2,4) CE(1,5) CE(3,7) CE(3,5) CE(1,2) CE(3,4) CE(5,6) CE(8,9) CE(10,11) CE(8,10) CE(9,11) CE(9,10) CE(12,13) CE(14,15) CE(12,14) CE(13,15) CE(13,14) CE(8,12) CE(10,14) CE(10,12) CE(9,13) CE(11,15) CE(11,13) CE(9,10) CE(11,12) CE(13,14) CE(0,8) CE(4,12) CE(4,8) CE(2,10) CE(6,14) CE(6,10) CE(2,4) CE(6,8) CE(10,12) CE(1,9) CE(5,13) CE(5,9) CE(3,11) CE(7,15) CE(7,11) CE(3,5) CE(7,9) CE(11,13) CE(1,2) CE(3,4) CE(5,6) CE(7,8) CE(9,10) CE(11,12) CE(13,14)
#undef CE
}
DI void bmerge16_desc(float (&a)[16]) {
#pragma unroll
    for (int j = 8; j > 0; j >>= 1)
#pragma unroll
        for (int i = 0; i < 16; ++i) { const int l = i ^ j; if (l > i) ce_desc(a[i], a[l]); }
}
DI void merge16(float (&a)[16], const float (&b)[16]) {
#pragma unroll
    for (int i = 0; i < 16; ++i) a[i] = fmax_raw(a[i], b[15 - i]);
    bmerge16_desc(a);
}
DI void ph_topk2(Frame& F) {
    const int lane = F.lane, c = lane & 31, h = lane >> 5;
    const bf16_t* q = (const bf16_t*)(F.a->ws + WS_R2);
    const bf16_t* kb = (const bf16_t*)(F.a->ws + WS_KB);
    int* tke = (int*)(F.a->ws + WS_R3); float* tkg = (float*)(F.a->ws + WS_TKG); float* tks = (float*)(F.a->ws + WS_TKS);
    const float2* suv = (const float2*)(F.a->ws + WS_SU);
    constexpr int KIMG = 2 * PNK * 272;
    unsigned char* ixl = F.lds + 2 * KIMG + F.wave * 2048 + c * 48;
    const int tid = F.tid;
    for (int tt0 = F.bid * NWV; tt0 < NTOK / 32; tt0 += F.G * NWV) {
        const int tt = tt0 + F.wave;
        const size_t tok = (size_t)tt * 32 + c;
        const bf16_t* qrow = q + tok * PROJ + 8 * h;
#define KLD(p, hd) kst##p = *(const uint4*)((const unsigned char*)kb + (ktofs + (unsigned)(p) * 8192u + (unsigned)(hd) * 65536u));
#define KST(p, bf) *(uint4*)(F.lds + (bf) * KIMG + ((tid + p * NT) >> 4) * 272 + ((tid + p * NT) & 15) * 16) = kst##p;
        uint4 kst0, kst1, kst2, kst3, kst4, kst5, kst6, kst7;
        const unsigned ktofs = (unsigned)(tid >> 4) * 256u + (unsigned)(tid & 15) * 16u;
        KLD(0, 0) KLD(1, 0) KLD(2, 0) KLD(3, 0) KLD(4, 0) KLD(5, 0) KLD(6, 0) KLD(7, 0)
        __syncthreads();
        KST(0, 0) KST(1, 0) KST(2, 0) KST(3, 0) KST(4, 0) KST(5, 0) KST(6, 0) KST(7, 0)
        __syncthreads();
#pragma unroll 1
        for (int head = 0; head < PH; ++head) {
            float vv[2][16];
            const unsigned char* kimg = F.lds + (head & 1) * KIMG;
            bf16x8_t bqn[8];
#pragma unroll
            for (int ks = 0; ks < 8; ++ks) bqn[ks] = *(const bf16x8_t*)(qrow + (head * 2) * PDH + ks * 16);
#pragma unroll
            for (int half = 0; half < 2; ++half) {
                const int list = head * 2 + half;
                f32x16_t acc[4];
#pragma unroll
                for (int kt = 0; kt < 4; ++kt)
#pragma unroll
                    for (int i = 0; i < 16; ++i) acc[kt][i] = 0.f;
                const unsigned char* kl = kimg + (half * PNK + c) * 272 + 16 * h;
                bf16x8_t bq[8];
#pragma unroll
                for (int ks = 0; ks < 8; ++ks) bq[ks] = bqn[ks];
                if (half == 0) {
#pragma unroll
                    for (int ks = 0; ks < 8; ++ks) bqn[ks] = *(const bf16x8_t*)(qrow + (head * 2 + 1) * PDH + ks * 16);
                }
#pragma unroll
                for (int ks = 0; ks < 8; ++ks) {
#pragma unroll
                    for (int kt = 0; kt < 4; ++kt) {
                        const bf16x8_t ak = *(const bf16x8_t*)(kl + kt * 32 * 272 + ks * 32);
                        acc[kt] = __builtin_amdgcn_mfma_f32_32x32x16_bf16(ak, bq[ks], acc[kt], 0, 0, 0);
                    }
                }
                float g[4][16];
#pragma unroll
                for (int kt = 0; kt < 4; ++kt)
#pragma unroll
                    for (int i = 0; i < 16; ++i) { const unsigned u = (__float_as_uint(acc[kt][i]) & 0xFFFFFF84u) | (unsigned)(kt * 32 + (i & 3) + 8 * (i >> 2)); g[kt][i] = __uint_as_float(u); }
#pragma unroll
                for (int kt = 0; kt < 4; ++kt) sort16_desc(g[kt]);
                merge16(g[0], g[1]); merge16(g[2], g[3]); merge16(g[0], g[2]);
                float other[16];
#pragma unroll
                for (int i = 0; i < 16; ++i) { g[0][i] = __uint_as_float((__float_as_uint(g[0][i]) & 0xFFFFFFFBu) | (unsigned)(4 * h)); other[i] = __shfl_xor(g[0][i], 32); }
                merge16(g[0], other);
#pragma unroll
                for (int i = 0; i < 16; ++i) vv[half][i] = g[0][i];
                unsigned pk[4];
#pragma unroll
                for (int w = 0; w < 4; ++w) pk[w] = (__float_as_uint(g[0][4 * w]) & 127u) | ((__float_as_uint(g[0][4 * w + 1]) & 127u) << 8) | ((__float_as_uint(g[0][4 * w + 2]) & 127u) << 16) | ((__float_as_uint(g[0][4 * w + 3]) & 127u) << 24);
                if (h == 0) { uint4 o; o.x = pk[0]; o.y = pk[1]; o.z = pk[2]; o.w = pk[3]; *(uint4*)(ixl + half * 16) = o; }
            }
            if (head + 1 < PH) { KLD(0, head + 1) KLD(1, head + 1) KLD(2, head + 1) KLD(3, head + 1) KLD(4, head + 1) KLD(5, head + 1) KLD(6, head + 1) KLD(7, head + 1) }
            const float SENT = -3.0e38f;
            float G0[16], G1[16], G2[16], G3[16];
#define CAND(a, b) __uint_as_float((__float_as_uint(vv[0][a] + vv[1][b]) & 0xFFFFFF00u) | (unsigned)((a) * 16 + (b)))
#pragma unroll
            for (int b2 = 0; b2 < 16; ++b2) G0[b2] = CAND(0, b2);
#pragma unroll
            for (int b2 = 0; b2 < 8; ++b2) G1[b2] = CAND(1, b2);
#pragma unroll
            for (int a2 = 8; a2 < 16; ++a2) G1[8 + (15 - a2)] = CAND(a2, 0);
            bmerge16_desc(G1);
            G2[0] = CAND(2, 0); G2[1] = CAND(2, 1); G2[2] = CAND(2, 2); G2[3] = CAND(2, 3); G2[4] = CAND(2, 4);
            G2[5] = CAND(3, 0); G2[6] = CAND(3, 1); G2[7] = CAND(3, 2); G2[8] = CAND(3, 3);
            G2[9] = CAND(4, 0); G2[10] = CAND(4, 1); G2[11] = CAND(4, 2);
            G2[12] = CAND(5, 0); G2[13] = CAND(5, 1); G2[14] = CAND(6, 0); G2[15] = CAND(6, 1);
            sort16_desc(G2);
            G3[0] = CAND(7, 0); G3[1] = CAND(7, 1);
#pragma unroll
            for (int i = 2; i < 16; ++i) G3[i] = SENT;
#undef CAND
            merge16(G0, G1); merge16(G2, G3); merge16(G0, G2);
            asm volatile("s_waitcnt lgkmcnt(0)" ::: "memory");
            int ee[16]; float ex[16]; float den = 0.f;
            const float m0 = __uint_as_float(__float_as_uint(G0[0]) & 0xFFFFFF00u);
#pragma unroll
            for (int r = 0; r < 16; ++r) {
                const unsigned u = __float_as_uint(G0[r]); const unsigned a2 = (u >> 4) & 15u, b2 = u & 15u;
                const int i1 = ixl[a2], i2 = ixl[16 + b2];
                ee[r] = i1 * PNK + i2;
                ex[r] = __expf(__uint_as_float(u & 0xFFFFFF00u) - m0); den += ex[r];
            }
            const float rden = 1.f / den;
            {
                int es[8]; float xs[8]; float2 st[8];
#pragma unroll
                for (int j = 0; j < 8; ++j) { es[j] = h ? ee[8 + j] : ee[j]; xs[j] = h ? ex[8 + j] : ex[j]; }
#pragma unroll
                for (int j = 0; j < 8; ++j) st[j] = suv[es[j]];
                const size_t o = tok * 128 + head * PTK + 8 * h;
#pragma unroll
                for (int w = 0; w < 2; ++w) {
                    *(int4*)(tke + o + 4 * w) = make_int4(es[4 * w], es[4 * w + 1], es[4 * w + 2], es[4 * w + 3]);
                    *(float4*)(tkg + o + 4 * w) = make_float4(xs[4 * w] * rden * st[4 * w].y, xs[4 * w + 1] * rden * st[4 * w + 1].y, xs[4 * w + 2] * rden * st[4 * w + 2].y, xs[4 * w + 3] * rden * st[4 * w + 3].y);
                    *(float4*)(tks + o + 4 * w) = make_float4(st[4 * w].x, st[4 * w + 1].x, st[4 * w + 2].x, st[4 * w + 3].x);
                }
            }
            asm volatile("s_waitcnt lgkmcnt(0)" ::: "memory");
            if (head + 1 < PH) { KST(0, (head + 1) & 1) KST(1, (head + 1) & 1) KST(2, (head + 1) & 1) KST(3, (head + 1) & 1) KST(4, (head + 1) & 1) KST(5, (head + 1) & 1) KST(6, (head + 1) & 1) KST(7, (head + 1) & 1) }
            __syncthreads();
        }
    }
}


typedef short s16x4_t __attribute__((ext_vector_type(4)));
DI unsigned cvt_pk_bf16_f32(float lo, float hi) { unsigned r; asm("v_cvt_pk_bf16_f32 %0, %1, %2" : "=v"(r) : "v"(lo), "v"(hi)); return r; }
typedef __bf16 bf16x2n_t __attribute__((ext_vector_type(2)));
DI unsigned cvt_pk_safe(float lo, float hi) { const f32x2_t v = {lo, hi}; const bf16x2n_t b = __builtin_convertvector(v, bf16x2n_t); return __builtin_bit_cast(unsigned, b); }
DI s16x4_t lds_tr_read(const unsigned char* p) { return __builtin_bit_cast(s16x4_t, __builtin_amdgcn_ds_read_tr16_b64_v4i16((LAS s16x4_t*)p)); }
constexpr int S5_IMG = 32 * 72;
DI void ph_s5mfma(Frame& F) {
    const int lane = F.lane, cc = lane & 31, hh = lane >> 5;
    const float* lamp = (const float*)(F.a->ws + WS_LAM); const float* bbp = (const float*)(F.a->ws + WS_BB);
    const bf16_t* px = (const bf16_t*)(F.a->ws + WS_R2); const bf16_t* pc = (const bf16_t*)(F.a->ws + WS_PC);
    float* ytmp = (float*)(F.a->ws + WS_R1); bf16_t* gy = (bf16_t*)(F.a->ws + WS_GY);
    unsigned char* img = F.lds + F.wave * (4 * S5_IMG);
    const int asel = (cc >> 2) & 1, aoff = (cc & 3) + 4 * (cc >> 3);
    const int i16 = lane & 15, tq = i16 >> 2, tp = i16 & 3, blk = (lane >> 4) & 1;
    if (F.wave < 2) {
        for (int task = F.bid * 2 + F.wave; task < S5G * (NB / 2); task += F.G * 2) {
            const int g = task & 31, bp = task >> 5;
            const int bA = 2 * bp + asel;
            const int bD = 2 * bp + hh;
#pragma unroll 1
            for (int dr = 0; dr < 2; ++dr) {
                const int dg = dr * S5G + g;
                bf16x8_t Bf[4];
                float lr[2], li[2];
#pragma unroll
                for (int set = 0; set < 2; ++set) {
                    const int st = 32 * set + cc;
                    lr[set] = lamp[(dg * S5P + st) * 2]; li[set] = lamp[(dg * S5P + st) * 2 + 1];
#pragma unroll
                    for (int j = 0; j < 8; ++j) {
                        Bf[2 * set][j] = (short)f2bf(bbp[((size_t)(dg * S5P + st) * S5H + 8 * hh + j) * 2]);
                        Bf[2 * set + 1][j] = (short)f2bf(bbp[((size_t)(dg * S5P + st) * S5H + 8 * hh + j) * 2 + 1]);
                    }
                }
                bf16x8_t Cf[8];
#pragma unroll
                for (int T = 0; T < 4; ++T)
#pragma unroll
                    for (int sk = 0; sk < 2; ++sk)
#pragma unroll
                        for (int j = 0; j < 8; ++j) {
                            const int st = 32 * (T >> 1) + 16 * sk + 8 * hh + j;
                            float v = 0.f;
                            if (cc < S5H) v = (T & 1) ? -F.a->in[16][((size_t)dg * S5H + cc) * S5P + st] : F.a->in[15][((size_t)dg * S5H + cc) * S5P + st];
                            Cf[T * 2 + sk][j] = (short)f2bf(v);
                        }
                bf16x8_t Dg;
#pragma unroll
                for (int j = 0; j < 8; ++j) Dg[j] = (short)((cc == 8 * hh + j) ? f2bf(F.a->in[17][g * S5H + cc]) : (bf16_t)0);
                float sr[2] = {0.f, 0.f}, si[2] = {0.f, 0.f};
#pragma unroll 1
                for (int tt = 0; tt < LC / 16; ++tt) {
                    const int t0 = dr == 0 ? tt * 16 : LC - 16 - tt * 16;
                    const bf16x8_t uf = *(const bf16x8_t*)(pc + ((size_t)bA * LC + t0 + aoff) * S5W + g * S5H + 8 * hh);
                    f32x16_t z;
#pragma unroll
                    for (int i = 0; i < 16; ++i) z[i] = 0.f;
                    f32x16_t bu[4];
#pragma unroll
                    for (int T = 0; T < 4; ++T) bu[T] = __builtin_amdgcn_mfma_f32_32x32x16_bf16(uf, Bf[T], z, 0, 0, 0);
#pragma unroll
                    for (int ii = 0; ii < 16; ++ii) {
                        const int i = dr == 0 ? ii : 15 - ii;
#pragma unroll
                        for (int set = 0; set < 2; ++set) {
                            const float nr = lr[set] * sr[set] - li[set] * si[set] + bu[2 * set][i], ni = lr[set] * si[set] + li[set] * sr[set] + bu[2 * set + 1][i];
                            sr[set] = nr; si[set] = ni;
                        }
                    }
                }
#pragma unroll 1
                for (int tt = 0; tt < SEQ / 16; ++tt) {
                    const int t0 = dr == 0 ? tt * 16 : SEQ - 16 - tt * 16;
                    const bf16x8_t uf = *(const bf16x8_t*)(px + ((size_t)bA * SEQ + t0 + aoff) * PROJ + g * S5H + 8 * hh);
                    f32x16_t z;
#pragma unroll
                    for (int i = 0; i < 16; ++i) z[i] = 0.f;
                    f32x16_t bu[4];
#pragma unroll
                    for (int T = 0; T < 4; ++T) bu[T] = __builtin_amdgcn_mfma_f32_32x32x16_bf16(uf, Bf[T], z, 0, 0, 0);
#pragma unroll
                    for (int ii = 0; ii < 16; ++ii) {
                        const int i = dr == 0 ? ii : 15 - ii;
#pragma unroll
                        for (int set = 0; set < 2; ++set) {
                            const float nr = lr[set] * sr[set] - li[set] * si[set] + bu[2 * set][i], ni = lr[set] * si[set] + li[set] * sr[set] + bu[2 * set + 1][i];
                            sr[set] = nr; si[set] = ni; bu[2 * set][i] = nr; bu[2 * set + 1][i] = ni;
                        }
                    }
#pragma unroll
                    for (int T = 0; T < 4; ++T)
#pragma unroll
                        for (int gq = 0; gq < 4; ++gq) {
                            uint2 w; w.x = cvt_pk_bf16_f32(bu[T][4 * gq], bu[T][4 * gq + 1]); w.y = cvt_pk_bf16_f32(bu[T][4 * gq + 2], bu[T][4 * gq + 3]);
                            *(uint2*)(img + T * S5_IMG + cc * 72 + 8 * (2 * gq + hh)) = w;
                        }
                    asm volatile("s_waitcnt lgkmcnt(0)" ::: "memory");
                    f32x16_t y = z;
                    if (dr == 0) y = __builtin_amdgcn_mfma_f32_32x32x16_bf16(uf, Dg, y, 0, 0, 0);
#pragma unroll
                    for (int T = 0; T < 4; ++T)
#pragma unroll
                        for (int sk = 0; sk < 2; ++sk) {
                            const s16x4_t lo = lds_tr_read(img + T * S5_IMG + (16 * sk + 8 * hh + tq) * 72 + 8 * (4 * blk + tp));
                            const s16x4_t hi = lds_tr_read(img + T * S5_IMG + (16 * sk + 8 * hh + 4 + tq) * 72 + 8 * (4 * blk + tp));
                            const bf16x8_t xa = __builtin_shufflevector(lo, hi, 0, 1, 2, 3, 4, 5, 6, 7);
                            y = __builtin_amdgcn_mfma_f32_32x32x16_bf16(xa, Cf[T * 2 + sk], y, 0, 0, 0);
                        }
                    asm volatile("s_waitcnt lgkmcnt(0)" ::: "memory");
                    if (cc < S5H) {
                        const size_t o0 = ((size_t)bD * SEQ + t0) * S5W + g * S5H + cc;
                        if (dr == 0) {
#pragma unroll
                            for (int i = 0; i < 16; ++i) ytmp[o0 + (size_t)i * S5W] = y[i];
                        } else {
#pragma unroll
                            for (int i = 0; i < 16; ++i) gy[o0 + (size_t)i * S5W] = f2bf(gelu_f(ytmp[o0 + (size_t)i * S5W] + y[i]));
                        }
                    }
                }
            }
        }
    }
}


typedef unsigned u32x4_t __attribute__((ext_vector_type(4)));
constexpr int HZS = 4112;
DI void ph_hyena(Frame& F) {
    unsigned char* Zl = F.lds; unsigned char* GRl = F.lds + 32 * HZS;
    const int tid = F.tid, lane = F.lane, cb = lane & 31, hh = lane >> 5;
    const int T0 = F.wave * 256;
    const bf16_t* qc = (const bf16_t*)(F.a->ws + WS_R3);
    const bf16_t* GR = (const bf16_t*)(F.a->ws + WS_GR);
    bf16_t* z3 = (bf16_t*)(F.a->ws + WS_Z3);
    for (int c = F.bid; c < HYW; c += F.G) {
        __syncthreads();
        {
            const bf16_t* zs = qc + ((size_t)(tid >> 8) * HYC3 + c) * SEQ + (tid & 255) * 8; unsigned char* zd = Zl + (tid >> 8) * HZS + (tid & 255) * 16;
#define ZLD(p) const uint4 zr##p = *(const uint4*)(zs + (size_t)(2 * p) * HYC3 * SEQ);
#define ZST(p) *(uint4*)(zd + (2 * p) * HZS) = zr##p;
            ZLD(0) ZLD(1) ZLD(2) ZLD(3) ZLD(4) ZLD(5) ZLD(6) ZLD(7) ZLD(8) ZLD(9) ZLD(10) ZLD(11) ZLD(12) ZLD(13) ZLD(14) ZLD(15)
            ZST(0) ZST(1) ZST(2) ZST(3) ZST(4) ZST(5) ZST(6) ZST(7) ZST(8) ZST(9) ZST(10) ZST(11) ZST(12) ZST(13) ZST(14) ZST(15)
#undef ZLD
#undef ZST
        }
#pragma unroll
        for (int o = 0; o < 2; ++o) *(uint4*)(GRl + o * 8192 + tid * 16) = *(const uint4*)(GR + (size_t)(o * HYW + c) * 4096 + tid * 8);
        __syncthreads();
#pragma unroll 1
        for (int o = 0; o < 2; ++o) {
            f32x16_t acc[8];
#pragma unroll
            for (int a = 0; a < 8; ++a)
#pragma unroll
                for (int i = 0; i < 16; ++i) acc[a][i] = 0.f;
            const LAS u32x4_t* wp4 = (const LAS u32x4_t*)(LAS unsigned char*)(GRl + o * 8192 + 2 * (2040 - T0 - 8 * cb + 8 * hh));
            const LAS bf16x8_t* zp8 = (const LAS bf16x8_t*)(LAS unsigned char*)(Zl + cb * HZS + 16 * hh);
#define HY_STEP(W0, W1, BZ) { const unsigned w[8] = {W0.x, W0.y, W0.z, W0.w, W1.x, W1.y, W1.z, W1.w}; \
                _Pragma("unroll") for (int a = 0; a < 8; ++a) { const int e = a >> 1; u32x4_t f; \
                    if ((a & 1) == 0) { f.x = w[4 - e]; f.y = w[5 - e]; f.z = w[6 - e]; f.w = w[7 - e]; } \
                    else { f.x = __builtin_amdgcn_alignbit(w[4 - e], w[3 - e], 16); f.y = __builtin_amdgcn_alignbit(w[5 - e], w[4 - e], 16); f.z = __builtin_amdgcn_alignbit(w[6 - e], w[5 - e], 16); f.w = __builtin_amdgcn_alignbit(w[7 - e], w[6 - e], 16); } \
                    acc[a] = __builtin_amdgcn_mfma_f32_32x32x16_bf16(__builtin_bit_cast(bf16x8_t, f), BZ, acc[a], 0, 0, 0); } }
            u32x4_t wa0 = wp4[0], wa1 = wp4[1]; bf16x8_t bza = zp8[0];
            u32x4_t wb0, wb1; bf16x8_t bzb;
#pragma unroll 1
            for (int ks = 0; ks < SEQ / 16; ks += 2) {
                wb0 = wp4[2 * ks + 2]; wb1 = wp4[2 * ks + 3]; bzb = zp8[2 * ks + 2];
                HY_STEP(wa0, wa1, bza)
                if (ks + 2 < SEQ / 16) { wa0 = wp4[2 * ks + 4]; wa1 = wp4[2 * ks + 5]; bza = zp8[2 * ks + 4]; }
                HY_STEP(wb0, wb1, bzb)
            }
#undef HY_STEP
            const float dd = F.a->in[29][o * HYW + c];
            const bf16_t* gate = qc + ((size_t)cb * HYC3 + (o + 1) * HYW + c) * SEQ;
            uint4 gqa[16];
#pragma unroll
            for (int i = 0; i < 16; ++i) gqa[i] = *(const uint4*)(gate + T0 + 8 * ((i & 3) + 8 * (i >> 2) + 4 * hh));
            __syncthreads();
#pragma unroll
            for (int i = 0; i < 16; ++i) {
                const int t = T0 + 8 * ((i & 3) + 8 * (i >> 2) + 4 * hh);
                const uint4 gq = gqa[i];
                const uint4 zq = *(const uint4*)(Zl + cb * HZS + 2 * t);
                const unsigned gw[4] = {gq.x, gq.y, gq.z, gq.w}, zw[4] = {zq.x, zq.y, zq.z, zq.w};
                float r[8];
#pragma unroll
                for (int a = 0; a < 8; ++a) {
                    const float gv = (a & 1) ? __uint_as_float(gw[a >> 1] & 0xffff0000u) : __uint_as_float(gw[a >> 1] << 16);
                    const float zv = (a & 1) ? __uint_as_float(zw[a >> 1] & 0xffff0000u) : __uint_as_float(zw[a >> 1] << 16);
                    r[a] = gv * (acc[a][i] + dd * zv);
                }
                uint4 ov; ov.x = cvt_pk_bf16_f32(r[0], r[1]); ov.y = cvt_pk_bf16_f32(r[2], r[3]); ov.z = cvt_pk_bf16_f32(r[4], r[5]); ov.w = cvt_pk_bf16_f32(r[6], r[7]);
                if (o == 0) *(uint4*)(Zl + cb * HZS + 2 * t) = ov;
                else *(uint4*)(z3 + ((size_t)cb * HYW + c) * SEQ + t) = ov;
            }
            if (o == 0) __syncthreads();
        }
    }
}


DI void ph_s5tab(Frame& F) {
    uint4* tab = (uint4*)(F.a->ws + WS_S5T);
    for (int e = F.bid * NT + F.tid; e < 64 * 13 * 64; e += F.G * NT) {
        const int lane = e & 63, f = (e >> 6) % 13, dg = e / (13 * 64), g = dg & 31, cc = lane & 31, hh = lane >> 5;
        float v[8];
        if (f < 4) {
            const int set = f >> 1, st = 32 * set + cc;
            const float ar = F.a->in[10][dg * S5P + st], ai = F.a->in[11][dg * S5P + st];
            const float step = expf(F.a->in[12][dg]);
            const float mag = expf(ar * step);
            const float lr = mag * cosf(ai * step), li = mag * sinf(ai * step);
            const float nr = lr - 1.f, ni = li, den = ar * ar + ai * ai;
            const float fr = (nr * ar + ni * ai) / den, fi = (ni * ar - nr * ai) / den;
#pragma unroll
            for (int j = 0; j < 8; ++j) {
                const float br = F.a->in[13][(size_t)(dg * S5P + st) * S5H + 8 * hh + j], bi = F.a->in[14][(size_t)(dg * S5P + st) * S5H + 8 * hh + j];
                v[j] = (f & 1) ? fr * bi + fi * br : fr * br - fi * bi;
            }
        } else if (f < 12) {
            const int T = (f - 4) >> 1, sk = (f - 4) & 1;
#pragma unroll
            for (int j = 0; j < 8; ++j) {
                const int st = 32 * (T >> 1) + 16 * sk + 8 * hh + j;
                v[j] = cc < S5H ? ((T & 1) ? -F.a->in[16][((size_t)dg * S5H + cc) * S5P + st] : F.a->in[15][((size_t)dg * S5H + cc) * S5P + st]) : 0.f;
            }
        } else {
#pragma unroll
            for (int j = 0; j < 8; ++j) v[j] = (cc == 8 * hh + j) ? F.a->in[17][g * S5H + cc] : 0.f;
        }
        tab[e] = make_uint4(pk2(v[0], v[1]), pk2(v[2], v[3]), pk2(v[4], v[5]), pk2(v[6], v[7]));
    }
}

constexpr int S5CH = 128, S5NQ = 18;
DI void s5_consts_B(const float* lamp, const uint4* tab, int dg, int cc, int lane, bf16x8_t (&Bf)[4], float (&lr)[2], float (&li)[2]) {
    const uint4* tp = tab + (size_t)dg * (13 * 64) + lane;
#pragma unroll
    for (int T = 0; T < 4; ++T) Bf[T] = __builtin_bit_cast(bf16x8_t, tp[T * 64]);
#pragma unroll
    for (int set = 0; set < 2; ++set) { const float2 l2 = *(const float2*)(lamp + (dg * S5P + 32 * set + cc) * 2); lr[set] = l2.x; li[set] = l2.y; }
}
DI void s5_consts_C(const uint4* tab, int dg, int lane, bf16x8_t (&Cf)[8], bf16x8_t& Dg) {
    const uint4* tp = tab + (size_t)dg * (13 * 64) + lane;
#pragma unroll
    for (int T = 0; T < 8; ++T) Cf[T] = __builtin_bit_cast(bf16x8_t, tp[(4 + T) * 64]);
    Dg = __builtin_bit_cast(bf16x8_t, tp[12 * 64]);
}
DI void cpow128(float lr, float li, float& pr, float& pi) {
    pr = lr; pi = li;
#pragma unroll
    for (int k = 0; k < 7; ++k) { const float nr = pr * pr - pi * pi, ni = 2.f * pr * pi; pr = nr; pi = ni; }
}
template <int DR, bool WB>
DI void s5_tile_scan(const bf16x8_t uf, const bf16x8_t (&Bf)[4], const float (&lr)[2], const float (&li)[2], float (&sr)[2], float (&si)[2], f32x16_t (&bu)[4]) {
    f32x16_t z;
#pragma unroll
    for (int i = 0; i < 16; ++i) z[i] = 0.f;
#pragma unroll
    for (int T = 0; T < 4; ++T) bu[T] = __builtin_amdgcn_mfma_f32_32x32x16_bf16(uf, Bf[T], z, 0, 0, 0);
#pragma unroll
    for (int ii = 0; ii < 16; ++ii) {
        constexpr int dummy = 0; (void)dummy;
        const int i = DR == 0 ? ii : 15 - ii;
#pragma unroll
        for (int set = 0; set < 2; ++set) {
            const float nr = __builtin_fmaf(lr[set], sr[set], __builtin_fmaf(-li[set], si[set], bu[2 * set][i])), ni = __builtin_fmaf(lr[set], si[set], __builtin_fmaf(li[set], sr[set], bu[2 * set + 1][i]));
            sr[set] = nr; si[set] = ni;
            if (WB) { bu[2 * set][i] = nr; bu[2 * set + 1][i] = ni; }
        }
    }
}
template <int DR>
DI void s5_pass1_chunk(const bf16_t* src, size_t rstride, int base, int aoff, const bf16x8_t (&Bf)[4], const float (&lr)[2], const float (&li)[2], float (&sr)[2], float (&si)[2]) {
    bf16x8_t u[8];
#pragma unroll
    for (int tt = 0; tt < 8; ++tt) u[tt] = *(const bf16x8_t*)(src + (size_t)(base + 16 * tt + aoff) * rstride);
#pragma unroll
    for (int tq = 0; tq < 8; ++tq) { f32x16_t bu[4]; s5_tile_scan<DR, false>(u[DR == 0 ? tq : 7 - tq], Bf, lr, li, sr, si, bu); }
}
DI void ph_s5pass1(Frame& F) {
    const int lane = F.lane, cc = lane & 31, hh = lane >> 5;
    const float* lamp = (const float*)(F.a->ws + WS_LAM); const float* bbp = (const float*)(F.a->ws + WS_BB);
    const bf16_t* px = (const bf16_t*)(F.a->ws + WS_R2); const bf16_t* pc = (const bf16_t*)(F.a->ws + WS_PC);
    float* Lp = (float*)(F.a->ws + WS_L);
    const int asel = (cc >> 2) & 1, aoff = (cc & 3) + 4 * (cc >> 3);
    for (int task = F.bid * NWV + F.wave; task < S5NQ * 64 * (NB / 2); task += F.G * NWV) {
        const int q = task % S5NQ, rest = task / S5NQ, dg = rest & 63, bp = rest >> 6, dr = dg >> 5, g = dg & 31;
        bf16x8_t Bf[4]; float lr[2], li[2];
        s5_consts_B(lamp, (const uint4*)(F.a->ws + WS_S5T), dg, cc, lane, Bf, lr, li);
        const int bA = 2 * bp + asel;
        const bf16_t* src; size_t rstride; int base;
        if (q < 2) { const int ck = dr == 0 ? q : 1 - q; base = ck * S5CH; src = pc + (size_t)bA * LC * S5W + g * S5H + 8 * hh; rstride = S5W; }
        else { const int ck = dr == 0 ? q - 2 : 17 - q; base = ck * S5CH; src = px + (size_t)bA * SEQ * PROJ + g * S5H + 8 * hh; rstride = PROJ; }
        float sr[2] = {0.f, 0.f}, si[2] = {0.f, 0.f};
        if (dr == 0) s5_pass1_chunk<0>(src, rstride, base, aoff, Bf, lr, li, sr, si);
        else s5_pass1_chunk<1>(src, rstride, base, aoff, Bf, lr, li, sr, si);
        float* lo = Lp + ((((size_t)(dr * S5NQ + q) * S5G + g) * NB + 2 * bp + hh) * S5P) * 2;
#pragma unroll
        for (int set = 0; set < 2; ++set) *(float2*)(lo + (32 * set + cc) * 2) = make_float2(sr[set], si[set]);
    }
}
template <int DR>
DI void s5_pass2_dir(Frame& F, const bf16_t* usrc, int g, int k, int bD, int cc, int hh, unsigned char* img, bf16_t* yl, bf16_t* gy,
                     const float* lamp, const float* bbp, const float* Lp) {
    const int lane = F.lane;
    const int i16 = lane & 15, tq = i16 >> 2, tp = i16 & 3, blk = (lane >> 4) & 1;
    const int dg = DR * S5G + g;
    bf16x8_t Bf[4]; float lr[2], li[2]; bf16x8_t Cf[8];
    s5_consts_B(lamp, (const uint4*)(F.a->ws + WS_S5T), dg, cc, lane, Bf, lr, li);
    float sr[2] = {0.f, 0.f}, si[2] = {0.f, 0.f};
    {
        float pr[2], pi[2];
        cpow128(lr[0], li[0], pr[0], pi[0]); cpow128(lr[1], li[1], pr[1], pi[1]);
        const int nq = DR == 0 ? k + 2 : 17 - k;
        const float* lq = Lp + ((((size_t)(DR * S5NQ) * S5G + g) * NB + bD) * S5P) * 2;
        float2 lv[17][2];
#pragma unroll
        for (int q = 0; q < 17; ++q)
#pragma unroll
            for (int set = 0; set < 2; ++set) lv[q][set] = (q < nq) ? *(const float2*)(lq + (size_t)q * (S5G * NB * S5P * 2) + (32 * set + cc) * 2) : make_float2(0.f, 0.f);
#pragma unroll
        for (int q = 0; q < 17; ++q)
#pragma unroll
            for (int set = 0; set < 2; ++set) {
                const float nr = pr[set] * sr[set] - pi[set] * si[set] + lv[q][set].x, ni = pr[set] * si[set] + pi[set] * sr[set] + lv[q][set].y;
                sr[set] = (q < nq) ? nr : sr[set]; si[set] = (q < nq) ? ni : si[set];
            }
    }
    asm volatile("" ::: "memory");
    bf16x8_t Dg;
    s5_consts_C((const uint4*)(F.a->ws + WS_S5T), dg, lane, Cf, Dg);
    const int base = k * S5CH;
    bf16x8_t ua = *(const bf16x8_t*)(usrc + (size_t)(16 * (DR == 0 ? 0 : 7)) * PROJ), ub = *(const bf16x8_t*)(usrc + (size_t)(16 * (DR == 0 ? 1 : 6)) * PROJ), uc = *(const bf16x8_t*)(usrc + (size_t)(16 * (DR == 0 ? 2 : 5)) * PROJ);
#pragma unroll
    for (int tn = 0; tn < 8; ++tn) {
        const int tt = DR == 0 ? tn : 7 - tn;
        const int tl0 = 16 * tt;
        const bf16x8_t ucur = ua; ua = ub; ub = uc;
        if (tn + 3 < 8) uc = *(const bf16x8_t*)(usrc + (size_t)(16 * (DR == 0 ? tn + 3 : 7 - (tn + 3))) * PROJ);
        f32x16_t bu[4];
        s5_tile_scan<DR, true>(ucur, Bf, lr, li, sr, si, bu);
#pragma unroll
        for (int T = 0; T < 4; ++T)
#pragma unroll
            for (int gq = 0; gq < 4; ++gq) {
                uint2 w; w.x = cvt_pk_bf16_f32(bu[T][4 * gq], bu[T][4 * gq + 1]); w.y = cvt_pk_bf16_f32(bu[T][4 * gq + 2], bu[T][4 * gq + 3]);
                *(uint2*)(img + T * 2048 + cc * 64 + 8 * (2 * gq + hh)) = w;
            }
        asm volatile("s_waitcnt lgkmcnt(0)" ::: "memory");
        f32x16_t y;
#pragma unroll
        for (int i = 0; i < 16; ++i) y[i] = 0.f;
        if (DR == 0) y = __builtin_amdgcn_mfma_f32_32x32x16_bf16(ucur, Dg, y, 0, 0, 0);
#pragma unroll
        for (int T = 0; T < 4; ++T)
#pragma unroll
            for (int sk = 0; sk < 2; ++sk) {
                const s16x4_t lo = lds_tr_read(img + T * 2048 + (16 * sk + 8 * hh + tq) * 64 + 8 * (4 * blk + tp));
                const s16x4_t hi = lds_tr_read(img + T * 2048 + (16 * sk + 8 * hh + 4 + tq) * 64 + 8 * (4 * blk + tp));
                const bf16x8_t xa = __builtin_shufflevector(lo, hi, 0, 1, 2, 3, 4, 5, 6, 7);
                y = __builtin_amdgcn_mfma_f32_32x32x16_bf16(xa, Cf[T * 2 + sk], y, 0, 0, 0);
            }
        asm volatile("s_waitcnt lgkmcnt(0)" ::: "memory");
        if (cc < S5H) {
            bf16_t* ylp = yl + ((size_t)tl0 * 2 + hh) * S5H + cc;
            if (DR == 0) {
#pragma unroll
                for (int i = 0; i < 16; ++i) ylp[i * 2 * S5H] = (bf16_t)cvt_pk_safe(y[i], y[i]);
            } else {
                bf16_t* gp = gy + ((size_t)bD * SEQ + base + tl0) * S5W + g * S5H + cc;
#pragma unroll
                for (int i = 0; i < 16; ++i) { const float gv = gelu_fast(bf2f(ylp[i * 2 * S5H]) + y[i]); gp[(size_t)i * S5W] = (bf16_t)cvt_pk_safe(gv, gv); }
            }
        }
        asm volatile("s_waitcnt lgkmcnt(0)" ::: "memory");
        __builtin_amdgcn_sched_barrier(0);
    }
}
DI void ph_s5pass2(Frame& F) {
    const int lane = F.lane, cc = lane & 31, hh = lane >> 5;
    const float* lamp = (const float*)(F.a->ws + WS_LAM); const float* bbp = (const float*)(F.a->ws + WS_BB);
    const bf16_t* px = (const bf16_t*)(F.a->ws + WS_R2);
    const float* Lp = (const float*)(F.a->ws + WS_L);
    bf16_t* gy = (bf16_t*)(F.a->ws + WS_GY);
    unsigned char* img = F.lds + F.wave * 8192;
    bf16_t* yl = (bf16_t*)(F.lds + 65536 + F.wave * 8192);
    const int asel = (cc >> 2) & 1, aoff = (cc & 3) + 4 * (cc >> 3);
#pragma unroll 1
    for (int task = F.bid * NWV + F.wave; task < 16 * S5G * (NB / 2); task += F.G * NWV) {
        const int g = task & 31, k = (task >> 5) & 15, bp = task >> 9;
        const int bA = 2 * bp + asel, bD = 2 * bp + hh;
        const bf16_t* src = px + (size_t)bA * SEQ * PROJ + g * S5H + 8 * hh;
        const bf16_t* usrc = src + (size_t)(k * S5CH + aoff) * PROJ;
        s5_pass2_dir<0>(F, usrc, g, k, bD, cc, hh, img, yl, gy, lamp, bbp, Lp);
        s5_pass2_dir<1>(F, usrc, g, k, bD, cc, hh, img, yl, gy, lamp, bbp, Lp);
    }
}


DI void ph_tabprep4(Frame& F, int it_lo, int it_hi, int wg, int nwg) {
    const int lane = F.lane, sl = lane & 31, half = lane >> 5;
    float4 nx[8];
    if (it_lo + wg * NWV + F.wave >= it_hi) return;
    {   const int it = it_lo + wg * NWV + F.wave; const int tab = it >> 13, row = 2 * (it & 8191) + half;
        const float* src = (tab ? F.a->in[37] : F.a->in[36]) + (size_t)row * DM + sl * 32;
#pragma unroll
        for (int j = 0; j < 8; ++j) nx[j] = *(const float4*)(src + 4 * j); }
#pragma unroll 1
    for (int it = it_lo + wg * NWV + F.wave; it < it_hi; it += nwg * NWV) {
        const int tab = it >> 13, row = 2 * (it & 8191) + half;
        float x[32]; float ssq = 0.f, amax = 0.f;
#pragma unroll
        for (int j = 0; j < 8; ++j) { const float4 t = nx[j]; x[4 * j] = t.x; x[4 * j + 1] = t.y; x[4 * j + 2] = t.z; x[4 * j + 3] = t.w; }
        {   const int itn = it + nwg * NWV;
            if (itn < it_hi) { const int tabn = itn >> 13, rown = 2 * (itn & 8191) + half; const float* srcn = (tabn ? F.a->in[37] : F.a->in[36]) + (size_t)rown * DM + sl * 32;
#pragma unroll
                for (int j = 0; j < 8; ++j) nx[j] = *(const float4*)(srcn + 4 * j); } }
#pragma unroll
        for (int j = 0; j < 32; ++j) { ssq += x[j] * x[j]; amax = fmaxf(amax, fabsf(x[j])); }
        ssq = half_sum(ssq, lane); amax = half_max(amax, lane);
        float step = fmaxf(0.335f * sqrtf(ssq * (1.f / DM)), amax * (1.f / 12.f));
        if (!(step > 0.f)) step = 1.f;
        const float inv = 1.f / step;
        unsigned w[4];
#pragma unroll
        for (int i = 0; i < 4; ++i) {
            unsigned ww = 0u;
#pragma unroll
            for (int b = 0; b < 4; ++b) {
                const int lo = (int)fminf(fmaxf(rintf(x[8 * i + b] * inv), -8.f), 7.f) + 8, hi = (int)fminf(fmaxf(rintf(x[8 * i + 4 + b] * inv), -8.f), 7.f) + 8;
                ww |= tab ? (((unsigned)lo << (4 * b)) | ((unsigned)hi << (4 * b + 16))) : (((unsigned)(lo ^ 8) << (4 * b)) | ((unsigned)(hi ^ 8) << (4 * b + 16)));
            }
            w[i] = ww;
        }
        *(uint4*)(F.a->ws + (tab ? WS_V4 : WS_U4) + (size_t)row * 512 + sl * 16) = make_uint4(w[0], w[1], w[2], w[3]);
        if (sl == 0) ((float*)(F.a->ws + WS_SU))[2 * row + tab] = step;
    }
}

DI float reduce8h(const float (&v)[8], int lane) {
    const bool b4 = (lane & 16) != 0, b3 = (lane & 8) != 0, b2 = (lane & 4) != 0;
    float a[4], b[2];
#pragma unroll
    for (int j = 0; j < 4; ++j) { const float send = b4 ? v[j] : v[j + 4], keep = b4 ? v[j + 4] : v[j]; a[j] = keep + __shfl_xor(send, 16); }
#pragma unroll
    for (int j = 0; j < 2; ++j) { const float send = b3 ? a[j] : a[j + 2], keep = b3 ? a[j + 2] : a[j]; b[j] = keep + __shfl_xor(send, 8); }
    const float send = b2 ? b[0] : b[1], keep = b2 ? b[1] : b[0];
    float x = keep + __shfl_xor(send, 4);
    x += __shfl_xor(x, 1); x += __shfl_xor(x, 2);
    return x;
}
DI void ph_gather4(Frame& F) {
    const int lane = F.lane, sl = lane & 31, half = lane >> 5;
    const float* tks = (const float*)(F.a->ws + WS_TKS);
    const int* tke = (const int*)(F.a->ws + WS_R3); const float* tkg = (const float*)(F.a->ws + WS_TKG);
    const bf16_t* hx2 = (const bf16_t*)(F.a->ws + WS_R1);
    const int jj = lane & 15, srcl = ((jj & 1) << 5) | (((jj >> 3) & 1) << 4) | (((jj >> 2) & 1) << 3) | (((jj >> 1) & 1) << 2);
    int* lew = (int*)(F.lds + F.wave * 512);
    const int* le = lew + half;
    const unsigned char* u4_base = F.a->ws + WS_U4; const unsigned char* v4_base = F.a->ws + WS_V4; const unsigned sl16 = (unsigned)sl * 16u;
#define G4_LOAD(buf, tab, h64_, bb_) _Pragma("unroll") for (int kk = 0; kk < 8; ++kk) { const int e = le[(h64_) * 64 + (bb_) * 16 + 2 * kk]; buf[kk] = *(const uint4*)(tab##_base + ((unsigned)e * 512u + sl16)); }
#define G4_U(buf, h64_, bb_) { float part[8]; _Pragma("unroll") for (int kk = 0; kk < 8; ++kk) { const unsigned w[4] = {buf[kk].x, buf[kk].y, buf[kk].z, buf[kk].w}; int dh = 0, dl = 0; \
        _Pragma("unroll") for (int i = 0; i < 4; ++i) { dh = __builtin_amdgcn_sdot8((int)w[i], Hhi[i], dh, false); dl = __builtin_amdgcn_sdot8((int)w[i], Hlo[i], dl, false); } part[kk] = (float)(16 * dh + dl); } \
        const float t2 = __shfl(reduce8h(part, lane), srcl); const float c = gvv[h64_] * gelu_fast(t2 * sue[h64_]) * sve[h64_]; cv[h64_] = ((lane >> 4) == (bb_)) ? c : cv[h64_]; }
#define G4_V(buf, h64_, bb_) _Pragma("unroll") for (int kk = 0; kk < 8; ++kk) { \
        const _Float16 c1 = lc[(h64_) * 64 + (bb_) * 16 + 2 * kk]; csum += (float)c1; const h2_t ch = {c1, c1}; const h2_t ch16 = ch * (h2_t){(_Float16)0.0625f, (_Float16)0.0625f}; \
        const unsigned w[4] = {buf[kk].x, buf[kk].y, buf[kk].z, buf[kk].w}; \
        _Pragma("unroll") for (int i = 0; i < 4; ++i) { const unsigned wh = w[i] >> 8; \
            acch[4 * i + 0] += ch * __builtin_bit_cast(h2_t, w[i] & 0x000F000Fu); acch[4 * i + 1] += ch16 * __builtin_bit_cast(h2_t, w[i] & 0x00F000F0u); \
            acch[4 * i + 2] += ch * __builtin_bit_cast(h2_t, wh & 0x000F000Fu); acch[4 * i + 3] += ch16 * __builtin_bit_cast(h2_t, wh & 0x00F000F0u); } }
    LAS int* cnt = (LAS int*)(LAS unsigned char*)(F.lds + 4096 + 65536);
    const int NPW = NTOK / F.G;
    _Float16* lcw = (_Float16*)(F.lds + 4096);
    for (int base = 0; base < NPW; base += 256) {
    const int nsl = NPW - base < 256 ? NPW - base : 256;
    if (F.tid == 0) { cnt[0] = 0; cnt[1] = 0; }
    __syncthreads();
    for (;;) {
        int slot = 0;
        if (lane == 0) slot = __hip_atomic_fetch_add(cnt, 1, __ATOMIC_RELAXED, __HIP_MEMORY_SCOPE_WORKGROUP);
        slot = __builtin_amdgcn_readfirstlane(slot);
        if (slot >= nsl) break;
        const int toki = F.bid * NWV + ((base + slot) & 7) + ((base + slot) >> 3) * (F.G * NWV);
        const size_t tok = toki;
        int Hhi[4], Hlo[4]; float hscale;
        {
            float hv[32]; float hm = 0.f;
#pragma unroll
            for (int q4 = 0; q4 < 4; ++q4) {
                const uint4 a = *(const uint4*)(hx2 + tok * DM + sl * 32 + q4 * 8);
                const unsigned w[4] = {a.x, a.y, a.z, a.w};
#pragma unroll
                for (int i = 0; i < 4; ++i) { hv[q4 * 8 + 2 * i] = __uint_as_float(w[i] << 16); hv[q4 * 8 + 2 * i + 1] = __uint_as_float(w[i] & 0xffff0000u); }
            }
#pragma unroll
            for (int j = 0; j < 32; ++j) hm = fmaxf(hm, fabsf(hv[j]));
            hm = half_max(hm, lane);
            hscale = hm > 0.f ? hm * (1.f / 119.f) : 1.f;
            const float hinv = 1.f / hscale;
#pragma unroll
            for (int i = 0; i < 4; ++i) {
                unsigned whi = 0u, wlo = 0u;
#pragma unroll
                for (int p = 0; p < 8; ++p) { const int q = (int)rintf(hv[8 * i + p] * hinv); const int lo = ((q + 8) & 15) - 8, hi = (q - lo) >> 4; wlo |= ((unsigned)lo & 15u) << (4 * p); whi |= ((unsigned)hi & 15u) << (4 * p); }
                Hhi[i] = (int)whi; Hlo[i] = (int)wlo;
            }
        }
        int ev[2]; float cv[2];
        uint4 bufA[8], bufB[8], bufC[8];
        ev[0] = tke[tok * 128 + lane]; ev[1] = tke[tok * 128 + 64 + lane];
        lew[lane] = ev[0]; lew[64 + lane] = ev[1];
        float gvv[2], sue[2], sve[2];
#pragma unroll
        for (int h64 = 0; h64 < 2; ++h64) { gvv[h64] = tkg[tok * 128 + h64 * 64 + lane]; sue[h64] = tks[tok * 128 + h64 * 64 + lane] * hscale; sve[h64] = 1.f; }
        cv[0] = 0.f; cv[1] = 0.f;
        G4_LOAD(bufA, u4, 0, 0) G4_LOAD(bufB, u4, 0, 1) __builtin_amdgcn_sched_barrier(0);
        G4_LOAD(bufC, u4, 0, 2) G4_U(bufA, 0, 0) __builtin_amdgcn_sched_barrier(0);
        G4_LOAD(bufA, u4, 0, 3) G4_U(bufB, 0, 1) __builtin_amdgcn_sched_barrier(0);
        G4_LOAD(bufB, u4, 1, 0) G4_U(bufC, 0, 2) __builtin_amdgcn_sched_barrier(0);
        G4_LOAD(bufC, u4, 1, 1) G4_U(bufA, 0, 3) __builtin_amdgcn_sched_barrier(0);
        G4_LOAD(bufA, u4, 1, 2) G4_U(bufB, 1, 0) __builtin_amdgcn_sched_barrier(0);
        G4_LOAD(bufB, u4, 1, 3) G4_U(bufC, 1, 1) __builtin_amdgcn_sched_barrier(0);
        G4_U(bufA, 1, 2) __builtin_amdgcn_sched_barrier(0);
        G4_U(bufB, 1, 3) __builtin_amdgcn_sched_barrier(0);
        lcw[slot * 128 + lane] = (_Float16)fminf(fmaxf(cv[0] * 16384.f, -60000.f), 60000.f); lcw[slot * 128 + 64 + lane] = (_Float16)fminf(fmaxf(cv[1] * 16384.f, -60000.f), 60000.f);
        asm volatile("s_waitcnt lgkmcnt(0)" ::: "memory");
    }
    __syncthreads();
    for (;;) {
        int slot = 0;
        if (lane == 0) slot = __hip_atomic_fetch_add(cnt + 1, 1, __ATOMIC_RELAXED, __HIP_MEMORY_SCOPE_WORKGROUP);
        slot = __builtin_amdgcn_readfirstlane(slot);
        if (slot >= nsl) break;
        const int toki = F.bid * NWV + ((base + slot) & 7) + ((base + slot) >> 3) * (F.G * NWV);
        const size_t tok = toki; const int b = toki / SEQ;
        const _Float16* lc = lcw + slot * 128 + half;
        uint4 bufA[8], bufB[8], bufC[8];
        lew[lane] = tke[tok * 128 + lane]; lew[64 + lane] = tke[tok * 128 + 64 + lane];
        float csum = 0.f;
        h2_t acch[16];
#pragma unroll
        for (int j = 0; j < 16; ++j) acch[j] = (h2_t){(_Float16)0.f, (_Float16)0.f};
        G4_LOAD(bufA, v4, 0, 0) G4_LOAD(bufB, v4, 0, 1) __builtin_amdgcn_sched_barrier(0);
        G4_LOAD(bufC, v4, 0, 2) G4_V(bufA, 0, 0) __builtin_amdgcn_sched_barrier(0);
        G4_LOAD(bufA, v4, 0, 3) G4_V(bufB, 0, 1) __builtin_amdgcn_sched_barrier(0);
        G4_LOAD(bufB, v4, 1, 0) G4_V(bufC, 0, 2) __builtin_amdgcn_sched_barrier(0);
        G4_LOAD(bufC, v4, 1, 1) G4_V(bufA, 0, 3) __builtin_amdgcn_sched_barrier(0);
        G4_LOAD(bufA, v4, 1, 2) G4_V(bufB, 1, 0) __builtin_amdgcn_sched_barrier(0);
        G4_LOAD(bufB, v4, 1, 3) G4_V(bufC, 1, 1) __builtin_amdgcn_sched_barrier(0);
        G4_V(bufA, 1, 2) __builtin_amdgcn_sched_barrier(0);
        G4_V(bufB, 1, 3) __builtin_amdgcn_sched_barrier(0);
        const float csb = csum * (8.f / 16384.f);
        float accf[16];
#pragma unroll
        for (int ii = 0; ii < 2; ++ii)
#pragma unroll
            for (int sq = 0; sq < 4; ++sq) {
                const float a0 = (float)acch[4 * ii + sq].x * 1024.f - csb, a1 = (float)acch[4 * ii + sq].y * 1024.f - csb, b0 = (float)acch[4 * (ii + 2) + sq].x * 1024.f - csb, b1 = (float)acch[4 * (ii + 2) + sq].y * 1024.f - csb;
                const float ta0 = a0 + __shfl_xor(a0, 32), ta1 = a1 + __shfl_xor(a1, 32), tb0 = b0 + __shfl_xor(b0, 32), tb1 = b1 + __shfl_xor(b1, 32);
                accf[8 * ii + sq] = half ? tb0 : ta0; accf[8 * ii + sq + 4] = half ? tb1 : ta1;
            }
        const int eoff = sl * 32 + 16 * half;
        const float* g2 = (const float*)(F.a->ws + WS_MOD) + (size_t)b * (6 * DM) + 5 * DM + eoff;
        float* xr = F.a->out + tok * DM + eoff;
        const float* gf = F.a->in[38] + eoff;
        float x1f[16];
        {
            const bf16_t* xb = (const bf16_t*)(F.a->ws + WS_X1B) + tok * DM + eoff;
            const uint4 xa = *(const uint4*)xb, xc = *(const uint4*)(xb + 8);
            const unsigned xw[8] = {xa.x, xa.y, xa.z, xa.w, xc.x, xc.y, xc.z, xc.w};
#pragma unroll
            for (int i = 0; i < 8; ++i) { x1f[2 * i] = __uint_as_float(xw[i] << 16); x1f[2 * i + 1] = __uint_as_float(xw[i] & 0xffff0000u); }
        }
        float xv[16]; float ss = 0.f;
#pragma unroll
        for (int j = 0; j < 4; ++j) {
            const float4 x4 = make_float4(x1f[4 * j], x1f[4 * j + 1], x1f[4 * j + 2], x1f[4 * j + 3]), g4 = *(const float4*)(g2 + 4 * j);
            xv[4 * j] = x4.x + g4.x * accf[4 * j]; xv[4 * j + 1] = x4.y + g4.y * accf[4 * j + 1]; xv[4 * j + 2] = x4.z + g4.z * accf[4 * j + 2]; xv[4 * j + 3] = x4.w + g4.w * accf[4 * j + 3];
            ss += xv[4 * j] * xv[4 * j] + xv[4 * j + 1] * xv[4 * j + 1] + xv[4 * j + 2] * xv[4 * j + 2] + xv[4 * j + 3] * xv[4 * j + 3];
        }
        ss = wave_sum(ss);
        const float rstd = rsqrtf(ss * (1.f / DM) + EPSF);
#pragma unroll
        for (int j = 0; j < 4; ++j) {
            const float4 f4 = *(const float4*)(gf + 4 * j);
            float4 o; o.x = xv[4 * j] * rstd * f4.x; o.y = xv[4 * j + 1] * rstd * f4.y; o.z = xv[4 * j + 2] * rstd * f4.z; o.w = xv[4 * j + 3] * rstd * f4.w;
            *(float4*)(xr + 4 * j) = o;
        }
    }
    __syncthreads();
    }
#undef G4_LOAD
#undef G4_U
#undef G4_V
}

constexpr int N_PHASES = 12;
#ifndef REP_MASK
#define REP_MASK 0u
#endif
__global__ void __launch_bounds__(NT, 2) fwd_megakernel(Args args) {
    extern __shared__ __attribute__((aligned(16))) unsigned char lds[];
    Frame F;
    F.lds = lds;
    F.tid = threadIdx.x; F.lane = F.tid & 63; F.wave = __builtin_amdgcn_readfirstlane(F.tid >> 6); F.G = gridDim.x; F.bid = blockIdx.x;
    F.a = &args;
    unsigned char* ws = args.ws;
    LAS unsigned char* ldsL = (LAS unsigned char*)lds;

    volatile LAS unsigned* MISC = (volatile LAS unsigned*)((LAS unsigned char*)lds + MISC_OFF);
    if (F.tid < 64) MISC[F.tid] = 0u;
    __syncthreads();
    const int lo = args.ph_lo, hi = args.ph_hi;
    const bool multi = (hi - lo) > 1;
    XcdBarrier bar; bar.bar = (unsigned*)(ws + WS_CTL); bar.x = 0; bar.st = nullptr;
    if (multi) bar = xcd_barrier_post((unsigned*)(ws + WS_CTL), MISC + 8);
#define IN(k) (lo <= (k) && (k) < hi)
#define REPS(k) for (int rep_ = 0; rep_ < (int)((REP_MASK >> (k)) & 1u) + 1; ++rep_, __syncthreads())
#define SEAM(k) do { if (IN(k) && IN((k) + 1)) xcd_barrier(bar); } while (0)

    if (IN(0)) { ph_mod(F); ph_s5prep(F); __syncthreads(); ph_filt_mlp(F); __syncthreads(); ph_wprep(F); ph_tabprep4(F, 0, 8192, F.bid, F.G); ph_keyprep(F); ph_s5tab(F); }
    SEAM(0);
    if (IN(1)) { ph_normmod(F, (F.a->in[0]), (F.a->in[2]), NTOK + NCTX, (F.a->in[6]), 0, 1, ((bf16_t*)(F.a->ws + WS_R1))); }
    SEAM(1);
    if (IN(2)) {
        pg8::Gemm g{(const bf16_t*)(ws + WS_R1), (const bf16_t*)(ws + WS_WINT), NTOK + NCTX, PROJ, DM}; pg8::OrderPx S; S.init(F.G, F.bid);
        pg8::EpiPxB E{(bf16_t*)(ws + WS_R2), (bf16_t*)(ws + WS_PC), args.in[9]};
        pg8::gemm_phase<pg8::EpiPxB, pg8::OrderPx, true, true>(ldsL, g, S, E);
        const int skip = F.G > 64 ? 64 : 0;
        if (F.bid >= skip) { __syncthreads(); ph_filt_fin(F, F.bid - skip, F.G - skip); ph_tabprep4(F, 8192, 16384, F.bid - skip, F.G - skip); }
    }
    SEAM(2);
    if (IN(3)) { ph_s5pass1(F); ph_shortconv(F); }
    SEAM(3);
    if (IN(4)) { ph_s5pass2(F); ph_hyena(F); }
    SEAM(4);
    const bool own57 = (F.G * 256 == NTOK) && IN(5) && IN(6) && IN(7);
    if (IN(5)) {
        { pg8::Gemm g{(const bf16_t*)(ws + WS_GY), (const bf16_t*)(ws + WS_WGLUT), NTOK, S5W, S5W}; pg8::OrderRowPair S; S.init(F.G, F.bid);
          pg8::EpiGluB E{(bf16_t*)(ws + WS_S5O), (const bf16_t*)(ws + WS_GY), args.in[19]};
          pg8::gemm_phase<pg8::EpiGluB, pg8::OrderRowPair, true, true>(ldsL, g, S, E); }
        __syncthreads();
        for (int rb = F.bid; rb < NTOK / 256; rb += F.G) ph_cat_s5(F, rb * 256, rb * 256 + 256);
        __syncthreads();
        if (own57) ph_cat_hy(F, 4 * F.bid, 4 * F.bid + 4, 1);
        else ph_cat_hy(F, F.bid, (SEQ / 64) * NB, F.G);
    }
    if (own57) { __syncthreads(); __builtin_amdgcn_fence(__ATOMIC_ACQUIRE, "agent"); } else { SEAM(5); SEAM(6); }
    if (IN(7)) {
        pg8::Gemm g{(const bf16_t*)(ws + WS_R1), (const bf16_t*)(ws + WS_WOUTT), NTOK, DM, DM}; pg8::OrderRowQuad S; S.init(F.G, F.bid);
        pg8::EpiResB E{(bf16_t*)(ws + WS_X1B), args.in[0], (const float*)(ws + WS_MOD) + 2 * DM};
        pg8::gemm_phase<pg8::EpiResB, pg8::OrderRowQuad, true, true>(ldsL, g, S, E);
        __syncthreads(); __builtin_amdgcn_fence(__ATOMIC_ACQUIRE, "agent");
        for (int rb = F.bid; rb < NTOK / 256; rb += F.G) ph_normmod_b(F, (const bf16_t*)(F.a->ws + WS_X1B), (F.a->in[7]), 3, 4, ((bf16_t*)(F.a->ws + WS_R1)), rb * 256, rb * 256 + 256);
    }
    SEAM(8);
    if (IN(9)) {
        pg8::Gemm g{(const bf16_t*)(ws + WS_R1), (const bf16_t*)(ws + WS_WQT), NTOK, PROJ, DM}; pg8::StaticOrder S; S.init(NTOK, PROJ, F.G, F.bid);
        pg8::EpiQB E{(bf16_t*)(ws + WS_R2)};
        pg8::gemm_phase<pg8::EpiQB, pg8::StaticOrder, true, true>(ldsL, g, S, E);
    }
    SEAM(9);
    if (IN(10)) ph_topk2(F);
    SEAM(10);
    if (IN(11)) ph_gather4(F);
#undef IN
#undef SEAM
}

#ifndef MK_PER_PHASE
#define MK_PER_PHASE 0
#endif
extern "C" void kernel_launch(void* const* d_in, const int* in_sizes, int n_in, void* d_out, int out_size, void* d_ws, size_t ws_size, hipStream_t stream) {
    static int grid = 0;
    if (grid == 0) {
        int dev = 0, cus = 0, per_cu = 0;
        if (hipGetDevice(&dev) != hipSuccess || hipDeviceGetAttribute(&cus, hipDeviceAttributeMultiprocessorCount, dev) != hipSuccess) { fprintf(stderr, "kernel_launch: device query failed\n"); grid = -1; return; }
        if (hipFuncSetAttribute((const void*)fwd_megakernel, hipFuncAttributeMaxDynamicSharedMemorySize, LDS_BYTES) != hipSuccess) { fprintf(stderr, "kernel_launch: hipFuncSetAttribute failed\n"); grid = -1; return; }
        if (hipOccupancyMaxActiveBlocksPerMultiprocessor(&per_cu, (const void*)fwd_megakernel, NT, LDS_BYTES) != hipSuccess || per_cu < 1) { fprintf(stderr, "kernel_launch: occupancy query says %d blocks per CU\n", per_cu); }
        (void)hipGetLastError();
        grid = cus;
    }
    if (grid < 0) return;
    (void)hipMemsetAsync((char*)d_ws + WS_CTL, 0, CTL_ZERO_BYTES, stream);
    Args a{};
    for (int i = 0; i < 39; ++i) a.in[i] = (const float*)d_in[i];
    a.out = (float*)d_out; a.ws = (unsigned char*)d_ws;
#if MK_PER_PHASE
    for (int p = 0; p < N_PHASES; ++p) { a.ph_lo = p; a.ph_hi = p + 1; hipLaunchKernelGGL(fwd_megakernel, dim3(grid), dim3(NT), LDS_BYTES, stream, a); }
#else
    a.ph_lo = 0; a.ph_hi = N_PHASES;
    hipLaunchKernelGGL(fwd_megakernel, dim3(grid), dim3(NT), LDS_BYTES, stream, a);
#endif
}
```

```cpp
#include <hip/hip_runtime.h>
#include <stdint.h>
#include <math.h>
#include <stdio.h>

#define DI __device__ __forceinline__
#define LAS __attribute__((address_space(3)))
typedef unsigned short bf16_t;

constexpr int NB = 32, SEQ = 2048, DM = 1024, LC = 256;
constexpr int NTOK = NB * SEQ;
constexpr int NCTX = NB * LC;
constexpr int PROJ = 2048;
constexpr int S5W = 512, S5H = 16, S5G = 32, S5P = 64;
constexpr int HYW = 512, HYC3 = 1536;
constexpr int GRIDW = 64;
constexpr int HFB = 16, HFE = 33, HFH = 64;
constexpr int PH = 8, PNK = 128, PDH = 128, PTK = 16;
constexpr float EPSF = 1e-6f;
constexpr int NT = 512, NWV = 8;

constexpr size_t MiB = 1u << 20;
constexpr size_t WS_CTL = 0, CTL_ZERO_BYTES = 16 * 1024;
constexpr size_t WS_MOD = 1 * MiB;
constexpr size_t WS_LAM = 2 * MiB;
constexpr size_t WS_BB = 3 * MiB;
constexpr size_t WS_HRAW = 4 * MiB;
constexpr size_t WS_G = 20 * MiB;
constexpr size_t WS_WINT = 36 * MiB, WS_WQT = 40 * MiB, WS_WOUTT = 44 * MiB, WS_WGLUT = 46 * MiB;
constexpr size_t WS_KB = 47 * MiB;
constexpr size_t WS_GR = 48 * MiB;
constexpr size_t WS_S5T = 57 * MiB;
constexpr size_t WS_R1 = 64 * MiB;
constexpr size_t WS_R2 = 216 * MiB;
constexpr size_t WS_PC = WS_R2 + 256 * MiB;
constexpr size_t WS_R3 = 480 * MiB;
constexpr size_t WS_TKG = WS_R3 + 32 * MiB;
constexpr size_t WS_Z3 = 672 * MiB;
constexpr size_t WS_GY = 736 * MiB;
constexpr size_t WS_S5O = 800 * MiB;
constexpr size_t WS_X1B = 544 * MiB;

constexpr size_t WS_U8 = 864 * MiB, WS_V8 = 880 * MiB;
constexpr size_t WS_SU = 896 * MiB, WS_SV = WS_SU + 65536;

constexpr size_t WS_U4 = 948 * MiB, WS_V4 = 956 * MiB;
constexpr size_t WS_L = 928 * MiB;

constexpr int LDS_BYTES = 163840;
constexpr int MISC_OFF = 163840 - 256;

DI float bf2f(bf16_t v) { return __uint_as_float(((unsigned)v) << 16); }
typedef float f32x2e_t __attribute__((ext_vector_type(2)));
typedef float f32x4_t __attribute__((ext_vector_type(4)));
typedef __bf16 bf16x2e_t __attribute__((ext_vector_type(2)));
DI bf16_t f2bf(float f) { return __builtin_bit_cast(bf16_t, (__bf16)f); }
DI unsigned pk2(float lo, float hi) { const f32x2e_t v = {lo, hi}; return __builtin_bit_cast(unsigned, __builtin_convertvector(v, bf16x2e_t)); }
DI float silu_f(float x) { return x / (1.f + expf(-x)); }
DI float sigmoid_f(float x) { return 1.f / (1.f + expf(-x)); }
DI float gelu_f(float x) { const float k = 0.7978845608028654f; return 0.5f * x * (1.f + tanhf(k * (x + 0.044715f * x * x * x))); }
DI float gelu_fast(float x) { const float u = x + 0.044715f * x * x * x; return x * __builtin_amdgcn_rcpf(1.f + __expf(-1.5957691216057308f * u)); }
template <int CTRL> DI float dpp_f(float v) { return __builtin_bit_cast(float, __builtin_amdgcn_update_dpp(0, __builtin_bit_cast(int, v), CTRL, 0xf, 0xf, true)); }
DI float rdlane_f(float v, int l) { return __builtin_bit_cast(float, __builtin_amdgcn_readlane(__builtin_bit_cast(int, v), l)); }
DI float row_sum(float v) { v += dpp_f<0xB1>(v); v += dpp_f<0x4E>(v); v += dpp_f<0x141>(v); v += dpp_f<0x140>(v); return v; }
DI float row_max(float v) { v = fmaxf(v, dpp_f<0xB1>(v)); v = fmaxf(v, dpp_f<0x4E>(v)); v = fmaxf(v, dpp_f<0x141>(v)); v = fmaxf(v, dpp_f<0x140>(v)); return v; }
DI float wave_sum(float v) { v = row_sum(v); return (rdlane_f(v, 0) + rdlane_f(v, 16)) + (rdlane_f(v, 32) + rdlane_f(v, 48)); }
DI float half_sum(float v, int lane) { v = row_sum(v); const float a = rdlane_f(v, 0) + rdlane_f(v, 16), b = rdlane_f(v, 32) + rdlane_f(v, 48); return lane < 32 ? a : b; }
DI float half_max(float v, int lane) { v = row_max(v); const float a = fmaxf(rdlane_f(v, 0), rdlane_f(v, 16)), b = fmaxf(rdlane_f(v, 32), rdlane_f(v, 48)); return lane < 32 ? a : b; }

#define XB_TMO      128
#define XB_XCNT(j)  (256  + 64 * (j))
#define XB_XSUB(j)  (1280 + 64 * (j))
#define XB_XGEN(j)  (2304 + 64 * (j))
#define XB_TOP      3328
#define XB_TOPGEN   3392
#define XCD_BAR_WORDS 3456
#define XB_SPIN_CAP (1u << 25)
DI unsigned xb_ld(unsigned* p)              { return __hip_atomic_load(p, __ATOMIC_RELAXED, __HIP_MEMORY_SCOPE_AGENT); }
DI unsigned xb_add(unsigned* p, unsigned v) { return __hip_atomic_fetch_add(p, v, __ATOMIC_RELAXED, __HIP_MEMORY_SCOPE_AGENT); }
DI unsigned xb_xcc_id() { return (unsigned)__builtin_amdgcn_s_getreg((3 << 11) | 20) & 0xFu; }
#define XB_SPIN(cond, bar) do { unsigned _sp = 0; while (cond) { __builtin_amdgcn_s_sleep(1); \
    if ((++_sp & 255u) == 0u) { if (xb_ld(&(bar)[XB_TMO])) break; if (_sp > XB_SPIN_CAP) { atomicAdd(&(bar)[XB_TMO], 1u); break; } } } } while (0)
struct XcdBarrier { unsigned* bar; unsigned x; volatile LAS unsigned* st; };
DI XcdBarrier xcd_barrier_post(unsigned* bar, volatile LAS unsigned* st) {
    XcdBarrier b; b.bar = bar; b.x = xb_xcc_id(); b.st = st;
    if (threadIdx.x == 0) (void)xb_add(&bar[XB_XCNT(b.x)], 1u);
    return b;
}
DI void xcd_barrier_complete(unsigned* bar, unsigned x, unsigned& nloc, unsigned& nx) {
    const unsigned G = gridDim.x * gridDim.y * gridDim.z;
    unsigned sum, cnt, mine, sp = 0u;
    for (;;) {
        sum = 0u; cnt = 0u; mine = 0u;
#pragma unroll
        for (unsigned j = 0; j < 16; ++j) { const unsigned c = xb_ld(&bar[XB_XCNT(j)]); sum += c; cnt += (c > 0u) ? 1u : 0u; mine = (j == x) ? c : mine; }
        if (sum == G) break;
        __builtin_amdgcn_s_sleep(1);
        if ((++sp & 255u) == 0u) { if (xb_ld(&bar[XB_TMO])) break; if (sp > XB_SPIN_CAP) { atomicAdd(&bar[XB_TMO], 1u); break; } }
    }
    nloc = mine > 0u ? mine : 1u; nx = cnt > 0u ? cnt : 1u;
}
DI void xcd_barrier(const XcdBarrier& b) {
    asm volatile("s_waitcnt vmcnt(0)" ::: "memory");
    __syncthreads();
    if (threadIdx.x == 0) {
        unsigned* bar = b.bar;
        __builtin_amdgcn_s_waitcnt(0);
        unsigned nloc = b.st[0], nx = b.st[1];
        if (nloc == 0u) { xcd_barrier_complete(bar, b.x, nloc, nx); b.st[0] = nloc; b.st[1] = nx; }
        const unsigned old = xb_add(&bar[XB_XSUB(b.x)], 1u);
        const unsigned gen = old / nloc;
        if (old + 1u == (gen + 1u) * nloc) {
            __builtin_amdgcn_fence(__ATOMIC_RELEASE, "agent");
            asm volatile("s_waitcnt vmcnt(0)" ::: "memory");
            const unsigned og = xb_add(&bar[XB_TOP], 1u);
            const unsigned tg = og / nx;
            if (og + 1u == (tg + 1u) * nx) xb_add(&bar[XB_TOPGEN], 1u);
            else XB_SPIN(xb_ld(&bar[XB_TOPGEN]) == tg, bar);
            __builtin_amdgcn_fence(__ATOMIC_ACQUIRE, "agent");
            xb_add(&bar[XB_XGEN(b.x)], 1u);
            asm volatile("s_waitcnt vmcnt(0)" ::: "memory");
        } else {
            XB_SPIN(xb_ld(&bar[XB_XGEN(b.x)]) == gen, bar);
            __builtin_amdgcn_fence(__ATOMIC_ACQUIRE, "agent");
            asm volatile("s_waitcnt vmcnt(0)" ::: "memory");
        }
    }
    __syncthreads();
}

namespace pg8 {
#define PG8_LAS __attribute__((address_space(3)))
typedef unsigned short bf16_t;
typedef short bf16x8 __attribute__((ext_vector_type(8)));
typedef float f32x4 __attribute__((ext_vector_type(4)));
typedef unsigned u32x4 __attribute__((ext_vector_type(4)));
constexpr int BM = 256, BK = 64, HALF = 128, HTB = HALF * BK * 2  , STAGE_BYTES = 8 * HTB, NXCD = 8, WGM = 8;

__host__ __device__ __forceinline__ int lds_byte(int r, int c) { const int st = (r >> 4) * 2 + (c >> 5), rr = r & 15, cc = c & 31, ob = rr * 64 + cc * 2; return st * 1024 + (ob ^ (((ob >> 9) & 1) << 5)); }
__host__ __device__ __forceinline__ void stage_rc(int b, int& R, int& C) { const int st = b / 1024, sb = b % 1024, swz = sb ^ (((sb >> 9) & 1) << 5); R = (st >> 1) * 16 + swz / 64; C = (st & 1) * 32 + (swz % 64) / 2; }
__host__ __device__ __forceinline__ int perm32(int rho) { const int n = rho >> 4, i = rho & 15; return 8 * (i >> 2) + 4 * n + (i & 3); }

struct Unit { int pm, pn; };
struct Gemm { const bf16_t* A; const bf16_t* Bt; int M, N, K; };

struct StaticOrder {
    int nM, nN, nwg, G, c;
    __host__ __device__ void init(int M, int N, int G_, int c_) { nM = M / BM; nN = N / BM; nwg = nM * nN; G = G_; c = c_; }
    __host__ __device__ bool next(int i, Unit& u) const {
        const long L = (long)i * G + c; if (L >= nwg) return false;
        int wgid = (int)L; { const int q = nwg / NXCD, r = nwg % NXCD, xcd = wgid % NXCD, off = wgid / NXCD; wgid = (xcd < r ? xcd * (q + 1) : r * (q + 1) + (xcd - r) * q) + off; }
        const int nig = WGM * nN, gid = wgid / nig, fm = gid * WGM, gsz = (nM - fm) < WGM ? (nM - fm) : WGM;
        u.pm = fm + ((wgid % nig) % gsz); u.pn = (wgid % nig) / gsz; return true;
    }
    __device__ __forceinline__ void a_ready(const Unit&) const {}
    __device__ __forceinline__ void done(const Unit&) const {}
};
__device__ __forceinline__ unsigned cvt_pk_bf16(float lo, float hi) { unsigned r; asm volatile("v_cvt_pk_bf16_f32 %0, %1, %2" : "=v"(r) : "v"(lo), "v"(hi)); return r; }

struct OrderRowPair {
    int G, c;
    __device__ __forceinline__ void init(int G_, int c_) { G = G_; c = c_; }
    __device__ __forceinline__ bool next(int i, Unit& u) const { const int pm = (i >> 1) * G + c; if (pm >= 256) return false; u.pm = pm; u.pn = i & 1; return true; }
    __device__ __forceinline__ void a_ready(const Unit&) const {}
    __device__ __forceinline__ void done(const Unit&) const {}
};
struct OrderRowQuad {
    int G, c;
    __device__ __forceinline__ void init(int G_, int c_) { G = G_; c = c_; }
    __device__ __forceinline__ bool next(int i, Unit& u) const { const int pm = (i >> 2) * G + c; if (pm >= 256) return false; u.pm = pm; u.pn = i & 3; return true; }
    __device__ __forceinline__ void a_ready(const Unit&) const {}
    __device__ __forceinline__ void done(const Unit&) const {}
};
struct OrderPx {
    StaticOrder so; int G, c;
    __device__ __forceinline__ void init(int G_, int c_) { so.init(65536, 2048, G_, c_); G = G_; c = c_; }
    __device__ __forceinline__ bool next(int i, Unit& u) const {
        if (so.next(i, u)) return true;
        const long L = (long)i * G + c - 2048; if (L < 0 || L >= 64) return false;
        u.pm = 256 + (int)(L >> 1); u.pn = (int)(L & 1); return true;
    }
    __device__ __forceinline__ void a_ready(const Unit&) const {}
    __device__ __forceinline__ void done(const Unit&) const {}
};
struct EpiPxB {
    static constexpr bool PERM = true, AFTER_DRAIN = false;
    bf16_t* px; bf16_t* pc; const float* bias;
    __device__ __forceinline__ void operator()(const f32x4 (&acc)[2][2][4][2], const Unit& u, int wr, int wc, int fr, int fq) const {
        const bool isctx = u.pm >= 256;
        bf16_t* base = isctx ? pc : px; const int ldc = isctx ? 512 : 2048; const int prow = isctx ? u.pm - 256 : u.pm;
        const int row0 = prow * BM + wr * 64 + fr, col0 = u.pn * BM + wc * 32 + 8 * fq;
        f32x4 bv[2][2];
#pragma unroll
        for (int bj = 0; bj < 2; ++bj)
#pragma unroll
            for (int n = 0; n < 2; ++n) bv[bj][n] = *(const f32x4*)(bias + col0 + bj * HALF + 4 * n);
#pragma unroll
        for (int ai = 0; ai < 2; ++ai)
#pragma unroll
            for (int m = 0; m < 4; ++m) { bf16_t* rowp = base + (size_t)(row0 + ai * HALF + m * 16) * ldc + col0;
#pragma unroll
                for (int bj = 0; bj < 2; ++bj) { const f32x4 v0 = acc[ai][bj][m][0] + bv[bj][0], v1 = acc[ai][bj][m][1] + bv[bj][1];
                    u32x4 w; w.x = cvt_pk_bf16(v0[0], v0[1]); w.y = cvt_pk_bf16(v0[2], v0[3]); w.z = cvt_pk_bf16(v1[0], v1[1]); w.w = cvt_pk_bf16(v1[2], v1[3]);
                    *(u32x4*)(rowp + bj * HALF) = w; } }
    }
};
struct EpiGluB {
    static constexpr bool PERM = true, AFTER_DRAIN = false;
    bf16_t* out; const bf16_t* gy; const float* bias;
    __device__ __forceinline__ void operator()(const f32x4 (&acc)[2][2][4][2], const Unit& u, int wr, int wc, int fr, int fq) const {
        const int row0 = u.pm * BM + wr * 64 + fr, col0 = u.pn * BM + wc * 32 + 8 * fq;
        f32x4 bv[2][2];
#pragma unroll
        for (int bj = 0; bj < 2; ++bj)
#pragma unroll
            for (int n = 0; n < 2; ++n) bv[bj][n] = *(const f32x4*)(bias + col0 + bj * HALF + 4 * n);
#pragma unroll
        for (int ai = 0; ai < 2; ++ai)
#pragma unroll
            for (int m = 0; m < 4; ++m) { const size_t off = (size_t)(row0 + ai * HALF + m * 16) * 512 + col0;
#pragma unroll
                for (int bj = 0; bj < 2; ++bj) { const f32x4 v0 = acc[ai][bj][m][0] + bv[bj][0], v1 = acc[ai][bj][m][1] + bv[bj][1];
                    const u32x4 g = *(const u32x4*)(gy + off + bj * HALF);
                    float o[8]; const float a[8] = {v0[0], v0[1], v0[2], v0[3], v1[0], v1[1], v1[2], v1[3]}; const unsigned gw[4] = {g.x, g.y, g.z, g.w};
#pragma unroll
                    for (int i = 0; i < 8; ++i) { const float gv = (i & 1) ? __uint_as_float(gw[i >> 1] & 0xffff0000u) : __uint_as_float(gw[i >> 1] << 16); o[i] = gv * __builtin_amdgcn_rcpf(1.f + __expf(-a[i])); }
                    u32x4 w; w.x = cvt_pk_bf16(o[0], o[1]); w.y = cvt_pk_bf16(o[2], o[3]); w.z = cvt_pk_bf16(o[4], o[5]); w.w = cvt_pk_bf16(o[6], o[7]);
                    *(u32x4*)(out + off + bj * HALF) = w; } }
    }
};
struct EpiResB {
    static constexpr bool PERM = true, AFTER_DRAIN = false;
    bf16_t* out; const float* x; const float* gate;
    __device__ __forceinline__ void operator()(const f32x4 (&acc)[2][2][4][2], const Unit& u, int wr, int wc, int fr, int fq) const {
        const int col0 = u.pn * BM + wc * 32 + 8 * fq; const float* gp = gate + (size_t)(u.pm >> 3) * 6144 + col0;
        f32x4 gv[2][2];
#pragma unroll
        for (int bj = 0; bj < 2; ++bj)
#pragma unroll
            for (int n = 0; n < 2; ++n) gv[bj][n] = *(const f32x4*)(gp + bj * HALF + 4 * n);
#pragma unroll
        for (int ai = 0; ai < 2; ++ai)
#pragma unroll
            for (int m = 0; m < 4; ++m) { const size_t off = (size_t)(u.pm * BM + ai * HALF + wr * 64 + m * 16 + fr) * 1024 + col0;
#pragma unroll
                for (int bj = 0; bj < 2; ++bj) { const f32x4 x0 = *(const f32x4*)(x + off + bj * HALF), x1 = *(const f32x4*)(x + off + bj * HALF + 4);
                    const f32x4 v0 = x0 + gv[bj][0] * acc[ai][bj][m][0], v1 = x1 + gv[bj][1] * acc[ai][bj][m][1];
                    u32x4 w; w.x = cvt_pk_bf16(v0[0], v0[1]); w.y = cvt_pk_bf16(v0[2], v0[3]); w.z = cvt_pk_bf16(v1[0], v1[1]); w.w = cvt_pk_bf16(v1[2], v1[3]);
                    *(u32x4*)(out + off + bj * HALF) = w; } }
    }
};
struct EpiQB {
    static constexpr bool PERM = true, AFTER_DRAIN = false;
    bf16_t* out;
    __device__ __forceinline__ void operator()(const f32x4 (&acc)[2][2][4][2], const Unit& u, int wr, int wc, int fr, int fq) const {
        const int row0 = u.pm * BM + wr * 64 + fr, col0 = u.pn * BM + wc * 32 + 8 * fq;
#pragma unroll
        for (int ai = 0; ai < 2; ++ai)
#pragma unroll
            for (int m = 0; m < 4; ++m) { bf16_t* rowp = out + (size_t)(row0 + ai * HALF + m * 16) * 2048 + col0;
#pragma unroll
                for (int bj = 0; bj < 2; ++bj) { const f32x4 v0 = acc[ai][bj][m][0], v1 = acc[ai][bj][m][1];
                    u32x4 w; w.x = cvt_pk_bf16(v0[0], v0[1]); w.y = cvt_pk_bf16(v0[2], v0[3]); w.z = cvt_pk_bf16(v1[0], v1[1]); w.w = cvt_pk_bf16(v1[2], v1[3]);
                    *(u32x4*)(rowp + bj * HALF) = w; } }
    }
};

template <class Epi, class Sched, bool ALIGN_EPI = false, bool SP2 = false>
__device__ __forceinline__ void gemm_phase(PG8_LAS unsigned char* lds, const Gemm g, const Sched& S, const Epi& E) {
    const int tid = threadIdx.x, wid = __builtin_amdgcn_readfirstlane(tid >> 6), lane = tid & 63, wr = wid >> 2, wc = wid & 3, fr = lane & 15, fq = lane >> 4;
    const int K = g.K, nt = K / BK;
    unsigned voffA[2], voffB[2];
#pragma unroll
    for (int i = 0; i < 2; ++i) { int R, C; stage_rc(tid * 16 + i * 8192, R, C); const int Rb = Epi::PERM ? ((R & ~31) + perm32(R & 31)) : R;
        voffA[i] = (unsigned)(R * K + C) * 2u; voffB[i] = (unsigned)(Rb * K + C) * 2u; }
    const size_t kstep = (size_t)(BK * 2);
    const size_t hstep = (size_t)HALF * K * 2;
    const size_t tstep = 2 * hstep;
    const unsigned ldsw = (unsigned)wid * 1024u;
    const int aoff = lds_byte(wr * 64 + fr, fq * 8), boff = lds_byte(wc * 32 + fr, fq * 8);
#define PG8_SA(b, h) (((b) * 2 + (h)) * HTB)
#define PG8_SB(b, h) ((4 + (b) * 2 + (h)) * HTB)
#define PG8_STAGE(bufoff, gbase, voff) do { _Pragma("unroll") for (int _i = 0; _i < 2; ++_i) \
        __builtin_amdgcn_global_load_lds((const unsigned*)((const char*)(gbase) + (voff)[_i]), (PG8_LAS unsigned*)(lds + (bufoff) + ldsw + _i * 8192), 16, 0, 0); } while (0)
#define PG8_LDA(dst, b, h) do { _Pragma("unroll") for (int m = 0; m < 4; ++m) _Pragma("unroll") for (int k = 0; k < 2; ++k) dst[m][k] = *(const PG8_LAS bf16x8*)(lds + PG8_SA(b, h) + aoff + m * 2048 + k * 1024); } while (0)
#define PG8_LDB(dst, b, h) do { _Pragma("unroll") for (int n = 0; n < 2; ++n) _Pragma("unroll") for (int k = 0; k < 2; ++k) dst[n][k] = *(const PG8_LAS bf16x8*)(lds + PG8_SB(b, h) + boff + n * 2048 + k * 1024); } while (0)
#define PG8_MMA(ai, bj, At, Bt) do { __builtin_amdgcn_s_setprio(1); _Pragma("unroll") for (int m = 0; m < 4; ++m) _Pragma("unroll") for (int n = 0; n < 2; ++n) _Pragma("unroll") for (int k = 0; k < 2; ++k) \
        acc[ai][bj][m][n] = __builtin_amdgcn_mfma_f32_16x16x32_bf16(Bt[n][k], At[m][k], acc[ai][bj][m][n], 0, 0, 0); __builtin_amdgcn_s_setprio(0); } while (0)
#define PG8_WAIT_V(n) asm volatile("s_waitcnt vmcnt(" #n ")" ::: "memory")
#define PG8_WAIT_L(n) asm volatile("s_waitcnt lgkmcnt(" #n ")" ::: "memory")
#define PG8_BAR __builtin_amdgcn_s_barrier()
#define PG8_SCHED __builtin_amdgcn_sched_barrier(0)
    Unit cur, nxt; int ui = 0;
    if (!S.next(0, cur)) return;
    f32x4 acc[2][2][4][2];
#pragma unroll
    for (int a = 0; a < 2; ++a)
#pragma unroll
        for (int b = 0; b < 2; ++b)
#pragma unroll
            for (int m = 0; m < 4; ++m)
#pragma unroll
                for (int n = 0; n < 2; ++n) acc[a][b][m][n] = (f32x4){0.f, 0.f, 0.f, 0.f};
    bf16x8 At[4][2], B0[2][2], B1[2][2];
    const char* cA = (const char*)g.A + (size_t)cur.pm * tstep; const char* cB = (const char*)g.Bt + (size_t)cur.pn * tstep;
    S.a_ready(cur);
    if constexpr (SP2) {
        PG8_STAGE(PG8_SB(0, 0), cB, voffB); PG8_STAGE(PG8_SB(0, 1), cB + hstep, voffB); PG8_STAGE(PG8_SA(0, 0), cA, voffA); PG8_STAGE(PG8_SA(0, 1), cA + hstep, voffA);
        if (wr == 1) PG8_BAR;
        PG8_WAIT_V(2); PG8_BAR;
        PG8_STAGE(PG8_SB(1, 0), cB + kstep, voffB); PG8_STAGE(PG8_SA(1, 0), cA + kstep, voffA); PG8_STAGE(PG8_SB(1, 1), cB + hstep + kstep, voffB);
        PG8_WAIT_V(6); PG8_BAR;
    } else {
        PG8_STAGE(PG8_SB(0, 0), cB, voffB); PG8_STAGE(PG8_SA(0, 0), cA, voffA); PG8_STAGE(PG8_SB(0, 1), cB + hstep, voffB); PG8_STAGE(PG8_SA(0, 1), cA + hstep, voffA);
        if (wr == 1) PG8_BAR;
        PG8_WAIT_V(4); PG8_BAR;
        PG8_STAGE(PG8_SB(1, 0), cB + kstep, voffB); PG8_STAGE(PG8_SA(1, 0), cA + kstep, voffA); PG8_STAGE(PG8_SB(1, 1), cB + hstep + kstep, voffB);
        PG8_WAIT_V(6); PG8_BAR;
    }
    for (;;) {
        const bool has_next = S.next(ui + 1, nxt);
        const char* nA = has_next ? (const char*)g.A + (size_t)nxt.pm * tstep : cA; const char* nB = has_next ? (const char*)g.Bt + (size_t)nxt.pn * tstep : cB;
        for (int t = 0; t < nt; t += 2) {
            const bool last = (t == nt - 2);
            const char* a1 = cA + (size_t)(t + 1) * kstep;
            const char* a2 = last ? nA : cA + (size_t)(t + 2) * kstep; const char* b2 = last ? nB : cB + (size_t)(t + 2) * kstep;
            const char* a3 = a2 + kstep; const char* b3 = b2 + kstep;
            if (last && has_next) S.a_ready(nxt);
            if constexpr (SP2) {
            PG8_LDB(B0, 0, 0); PG8_LDB(B1, 0, 1); PG8_SCHED; PG8_LDA(At, 0, 0); PG8_STAGE(PG8_SA(1, 1), a1 + hstep, voffA);
            PG8_WAIT_V(8); PG8_WAIT_L(0); PG8_BAR; PG8_MMA(0, 0, At, B0); PG8_MMA(0, 1, At, B1); PG8_BAR; PG8_SCHED;
            PG8_LDA(At, 0, 1); PG8_STAGE(PG8_SB(0, 0), b2, voffB); PG8_STAGE(PG8_SB(0, 1), b2 + hstep, voffB); PG8_STAGE(PG8_SA(0, 0), a2, voffA);
            PG8_WAIT_V(8); PG8_WAIT_L(0); PG8_BAR; PG8_MMA(1, 0, At, B0); PG8_MMA(1, 1, At, B1); PG8_BAR; PG8_SCHED;
            PG8_LDB(B0, 1, 0); PG8_LDB(B1, 1, 1); PG8_SCHED; PG8_LDA(At, 1, 0); PG8_STAGE(PG8_SA(0, 1), a2 + hstep, voffA);
            PG8_WAIT_V(8); PG8_WAIT_L(0); PG8_BAR; PG8_MMA(0, 0, At, B0); PG8_MMA(0, 1, At, B1); PG8_BAR; PG8_SCHED;
            PG8_LDA(At, 1, 1); PG8_STAGE(PG8_SB(1, 0), b3, voffB); PG8_STAGE(PG8_SB(1, 1), b3 + hstep, voffB); PG8_STAGE(PG8_SA(1, 0), a3, voffA);
            PG8_WAIT_V(8); PG8_WAIT_L(0); PG8_BAR; PG8_MMA(1, 0, At, B0); PG8_MMA(1, 1, At, B1); PG8_BAR; PG8_SCHED;
            } else {
            PG8_LDB(B0, 0, 0); PG8_SCHED; PG8_LDA(At, 0, 0); PG8_STAGE(PG8_SA(1, 1), a1 + hstep, voffA);
            PG8_WAIT_L(8); PG8_BAR; PG8_WAIT_L(0); PG8_MMA(0, 0, At, B0); PG8_BAR; PG8_SCHED;
            PG8_LDB(B1, 0, 1); PG8_STAGE(PG8_SB(0, 0), b2, voffB);
            PG8_BAR; PG8_WAIT_L(0); PG8_MMA(0, 1, At, B1); PG8_BAR;
            PG8_LDA(At, 0, 1); PG8_STAGE(PG8_SA(0, 0), a2, voffA);
            PG8_BAR; PG8_WAIT_L(0); PG8_MMA(1, 0, At, B0); PG8_BAR; PG8_SCHED;
            PG8_STAGE(PG8_SB(0, 1), b2 + hstep, voffB);
            PG8_WAIT_V(6); PG8_BAR; PG8_MMA(1, 1, At, B1); PG8_BAR;
            PG8_LDB(B0, 1, 0); PG8_SCHED; PG8_LDA(At, 1, 0); PG8_STAGE(PG8_SA(0, 1), a2 + hstep, voffA);
            PG8_WAIT_L(8); PG8_BAR; PG8_WAIT_L(0); PG8_MMA(0, 0, At, B0); PG8_BAR; PG8_SCHED;
            PG8_LDB(B1, 1, 1); PG8_STAGE(PG8_SB(1, 0), b3, voffB);
            PG8_BAR; PG8_WAIT_L(0); PG8_MMA(0, 1, At, B1); PG8_BAR;
            PG8_LDA(At, 1, 1); PG8_STAGE(PG8_SA(1, 0), a3, voffA);
            PG8_BAR; PG8_WAIT_L(0); PG8_MMA(1, 0, At, B0); PG8_BAR; PG8_SCHED;
            PG8_STAGE(PG8_SB(1, 1), b3 + hstep, voffB);
            PG8_WAIT_V(6); PG8_BAR; PG8_MMA(1, 1, At, B1); PG8_BAR;
            }
        }
        if constexpr (ALIGN_EPI) { if (wr == 0) PG8_BAR; }
        if constexpr (!Epi::AFTER_DRAIN) { E(acc, cur, wr, wc, fr, fq); S.done(cur); }
        if (!has_next) break;
#pragma unroll
        for (int a = 0; a < 2; ++a)
#pragma unroll
            for (int b = 0; b < 2; ++b)
#pragma unroll
                for (int m = 0; m < 4; ++m)
#pragma unroll
                    for (int n = 0; n < 2; ++n) acc[a][b][m][n] = (f32x4){0.f, 0.f, 0.f, 0.f};
        cur = nxt; cA = nA; cB = nB; ++ui;
        if constexpr (ALIGN_EPI) { if (wr == 1) PG8_BAR; }
    }
    PG8_WAIT_V(0);
    if constexpr (!ALIGN_EPI) { if (wr == 0) PG8_BAR; }
    PG8_BAR;
    if constexpr (Epi::AFTER_DRAIN) { E.fused(acc, cur, wr, wc, fr, fq, lds, wid, lane); S.done(cur); }
#undef PG8_SA
#undef PG8_SB
#undef PG8_STAGE
#undef PG8_LDA
#undef PG8_LDB
#undef PG8_MMA
#undef PG8_WAIT_V
#undef PG8_WAIT_L
#undef PG8_BAR
#undef PG8_SCHED
}
}

struct Args { const float* in[39]; float* out; unsigned char* ws; int ph_lo, ph_hi; };
struct Frame {
    unsigned char* lds;
    int tid, lane, wave, G, bid;
    const Args* a;
};

DI void ph_mod(Frame& F) {
    const int lane = F.lane, wave = F.wave, col = lane & 31, kh = lane >> 5;
    float* sl = (float*)F.lds + wave * (33 * 128);
    for (int it = F.bid; it < 6 * DM / 32; it += F.G) {
        __syncthreads();
#pragma unroll 33
        for (int e = lane; e < 33 * 128; e += 64) { const int row = e >> 7, kk = e & 127; const float* cv = row < NB ? F.a->in[1] + (size_t)row * DM : F.a->in[3]; const float x = cv[wave * 128 + kk]; sl[e] = x * __builtin_amdgcn_rcpf(1.f + __expf(-x)); }
        asm volatile("s_waitcnt lgkmcnt(0)" ::: "memory");
        float acc[33];
#pragma unroll
        for (int r = 0; r < 33; ++r) acc[r] = 0.f;
        const float* wp = F.a->in[4] + (size_t)(wave * 128 + kh * 64) * (6 * DM) + it * 32 + col;
        const float* sp = sl + kh * 64;
#pragma unroll 8
        for (int k4 = 0; k4 < 16; ++k4) {
            const float w0 = wp[(size_t)(4 * k4) * (6 * DM)], w1 = wp[(size_t)(4 * k4 + 1) * (6 * DM)], w2 = wp[(size_t)(4 * k4 + 2) * (6 * DM)], w3 = wp[(size_t)(4 * k4 + 3) * (6 * DM)];
#pragma unroll
            for (int r = 0; r < 33; ++r) { const float4 s4 = *(const float4*)(sp + r * 128 + 4 * k4); acc[r] += s4.x * w0; acc[r] += s4.y * w1; acc[r] += s4.z * w2; acc[r] += s4.w * w3; }
        }
#pragma unroll
        for (int r = 0; r < 33; ++r) acc[r] += __shfl_xor(acc[r], 32);
        asm volatile("s_waitcnt lgkmcnt(0)" ::: "memory");
        if (kh == 0) {
#pragma unroll
            for (int r = 0; r < 33; ++r) sl[r * 32 + col] = acc[r];
        }
        __syncthreads();
        for (int e = F.tid; e < 33 * 32; e += NT) {
            const int r = e >> 5, c = e & 31;
            float t = F.a->in[5][it * 32 + c];
#pragma unroll
            for (int w = 0; w < NWV; ++w) t += ((float*)F.lds)[w * (33 * 128) + r * 32 + c];
            ((float*)(F.a->ws + WS_MOD))[(size_t)r * (6 * DM) + it * 32 + c] = t;
        }
    }
}


DI void transpose_item(const float* W, int K, int N, bf16_t* WT, float* scr, int item, int lane) {
    const int nblk = N / 32, kb = item / nblk, nb = item % nblk, k0 = 64 * kb, n0 = 32 * nb;
#pragma unroll 32
    for (int i = 0; i < 32; ++i) { const int kk = 2 * i + (lane >> 5); scr[kk * 33 + (lane & 31)] = W[(size_t)(k0 + kk) * N + n0 + (lane & 31)]; }
    asm volatile("s_waitcnt lgkmcnt(0)" ::: "memory");
    const int c = lane & 7;
#pragma unroll
    for (int j = 0; j < 4; ++j) { const int n = (lane >> 3) + 8 * j; const float* sp = scr + (8 * c) * 33 + n;
        uint4 o; o.x = pk2(sp[0 * 33], sp[1 * 33]); o.y = pk2(sp[2 * 33], sp[3 * 33]); o.z = pk2(sp[4 * 33], sp[5 * 33]); o.w = pk2(sp[6 * 33], sp[7 * 33]);
        *(uint4*)(WT + (size_t)(n0 + n) * K + k0 + 8 * c) = o; }
    asm volatile("s_waitcnt lgkmcnt(0)" ::: "memory");
}
DI void ph_wprep(Frame& F) {
    float* scr = (float*)(F.lds + F.wave * 16384);
    const int gw = F.bid * NWV + F.wave, NGW = F.G * NWV;
    constexpr int I_IN = (DM / 64) * (PROJ / 32), I_GLU = (S5W / 64) * (S5W / 32), I_OUT = (DM / 64) * (DM / 32), I_Q = (DM / 64) * (PROJ / 32);
    for (int it = gw; it < I_IN + I_GLU + I_OUT + I_Q; it += NGW) {
        int r = it;
        if (r < I_IN) { transpose_item(F.a->in[8], DM, PROJ, (bf16_t*)(F.a->ws + WS_WINT), scr, r, F.lane); continue; } r -= I_IN;
        if (r < I_GLU) { transpose_item(F.a->in[18], S5W, S5W, (bf16_t*)(F.a->ws + WS_WGLUT), scr, r, F.lane); continue; } r -= I_GLU;
        if (r < I_OUT) { transpose_item(F.a->in[32], DM, DM, (bf16_t*)(F.a->ws + WS_WOUTT), scr, r, F.lane); continue; } r -= I_OUT;
        transpose_item(F.a->in[33], DM, PROJ, (bf16_t*)(F.a->ws + WS_WQT), scr, r, F.lane);
    }
}

DI void ph_s5prep(Frame& F) {
    const int gt = F.bid * NT + F.tid;
    if (gt < 2 * S5G * S5P) {
        const int dg = gt >> 6, p = gt & 63;
        const float ar = (F.a->in[10])[dg * S5P + p], ai = (F.a->in[11])[dg * S5P + p];
        const float step = expf((F.a->in[12])[dg]);
        const float mag = expf(ar * step);
        const float lr = mag * cosf(ai * step), li = mag * sinf(ai * step);
        ((float*)(F.a->ws + WS_LAM))[(dg * S5P + p) * 2 + 0] = lr; ((float*)(F.a->ws + WS_LAM))[(dg * S5P + p) * 2 + 1] = li;
        const float nr = lr - 1.f, ni = li, den = ar * ar + ai * ai;
        const float fr = (nr * ar + ni * ai) / den, fi = (ni * ar - nr * ai) / den;
        for (int h = 0; h < S5H; ++h) {
            const float br = (F.a->in[13])[(size_t)(dg * S5P + p) * S5H + h], bi = (F.a->in[14])[(size_t)(dg * S5P + p) * S5H + h];
            ((float*)(F.a->ws + WS_BB))[((size_t)(dg * S5P + p) * S5H + h) * 2 + 0] = fr * br - fi * bi;
            ((float*)(F.a->ws + WS_BB))[((size_t)(dg * S5P + p) * S5H + h) * 2 + 1] = fr * bi + fi * br;
        }
    }
}

DI void ph_filt_mlp(Frame& F) {
    float* feats = (float*)F.lds;
    float* hidA = feats + 64 * 34;
    float* hidB = hidA + 64 * 64;
    float* wl = hidB + 64 * 64;
    float* wst = wl + 64 * 256;
    const int tid = F.tid;
    float* hT = (float*)(F.a->ws + WS_HRAW);
    for (int it = F.bid; it < 32 * 8; it += F.G) {
        const int pb = it >> 3, cs = it & 7, pos0 = pb * 64, col0 = cs * 256;
        __syncthreads();
        for (int e = tid; e < 64 * 33; e += NT) {
            const int p = e / 33, f = e % 33, pos = pos0 + p;
            float v;
            if (f == 0) v = (float)pos / (float)(SEQ - 1);
            else { const int j = (f - 1) & 15; const float band = 1e-4f + (float)j * ((15.0f - 1e-4f) / 15.0f); const float ang = (6.283185307179586f / (float)SEQ) * (float)pos * band; v = f <= 16 ? cosf(ang) : -sinf(ang); }
            feats[p * 34 + f] = v;
        }
#pragma unroll 8
        for (int e = tid; e < 64 * 256; e += NT) { const int i = e >> 8, c = e & 255; wl[e] = F.a->in[27][(size_t)i * 2048 + col0 + c]; }
        for (int e = tid; e < HFE * HFH; e += NT) wst[e] = F.a->in[22][e];
        __syncthreads();
        const int p = tid >> 3, j0 = (tid & 7) * 8;
        {
            float a[8];
#pragma unroll
            for (int j = 0; j < 8; ++j) a[j] = F.a->in[23][j0 + j];
#pragma unroll 3
            for (int i = 0; i < HFE; ++i) { const float x = feats[p * 34 + i]; const float4 w0 = *(const float4*)(wst + i * HFH + j0), w1 = *(const float4*)(wst + i * HFH + j0 + 4);
                a[0] += x * w0.x; a[1] += x * w0.y; a[2] += x * w0.z; a[3] += x * w0.w; a[4] += x * w1.x; a[5] += x * w1.y; a[6] += x * w1.z; a[7] += x * w1.w; }
#pragma unroll
            for (int j = 0; j < 8; ++j) hidA[p * 64 + j0 + j] = sinf(F.a->in[26][j0 + j] * a[j]);
        }
        float* hin = hidA; float* hout = hidB;
        for (int l = 0; l < 2; ++l) {
            __syncthreads();
            for (int e = tid; e < HFH * HFH; e += NT) wst[e] = F.a->in[24][l * HFH * HFH + e];
            __syncthreads();
            float a[8];
#pragma unroll
            for (int j = 0; j < 8; ++j) a[j] = F.a->in[25][l * HFH + j0 + j];
#pragma unroll 4
            for (int i = 0; i < HFH; ++i) { const float x = hin[p * 64 + i]; const float4 w0 = *(const float4*)(wst + i * HFH + j0), w1 = *(const float4*)(wst + i * HFH + j0 + 4);
                a[0] += x * w0.x; a[1] += x * w0.y; a[2] += x * w0.z; a[3] += x * w0.w; a[4] += x * w1.x; a[5] += x * w1.y; a[6] += x * w1.z; a[7] += x * w1.w; }
#pragma unroll
            for (int j = 0; j < 8; ++j) hout[p * 64 + j0 + j] = sinf(F.a->in[26][j0 + j] * a[j]);
            float* t = hin; hin = hout; hout = t;
        }
        __syncthreads();
        {
            const int c = tid & 255, ph = tid >> 8, col = col0 + c;
            float w[64];
#pragma unroll
            for (int i = 0; i < 64; ++i) w[i] = wl[i * 256 + c];
            const float dec = fabsf(F.a->in[28][col]);
            float* op = hT + (size_t)col * SEQ + pos0 + ph * 32;
#pragma unroll 1
            for (int pq = 0; pq < 16; ++pq) {
                float o[2];
#pragma unroll
                for (int pi = 0; pi < 2; ++pi) {
                    const int pp = ph * 32 + pq * 2 + pi;
                    const float4* hp = (const float4*)(hin + pp * 64);
                    float acc = 0.f;
#pragma unroll
                    for (int i4 = 0; i4 < 16; ++i4) { const float4 h4 = hp[i4]; acc += h4.x * w[4 * i4] + h4.y * w[4 * i4 + 1] + h4.z * w[4 * i4 + 2] + h4.w * w[4 * i4 + 3]; }
                    const float t = (float)(pos0 + pp) / (float)(SEQ - 1);
                    o[pi] = acc * expf(-t * dec);
                }
                *(float2*)(op + pq * 2) = make_float2(o[0], o[1]);
            }
        }
    }
}

DI void ph_filt_fin(Frame& F, int wg, int nwg) {
    float* red = (float*)F.lds;
    const float* hT = (const float*)(F.a->ws + WS_HRAW);
    for (int it = wg; it < 2 * HYW; it += nwg) {
        const int o = it >> 9, c = it & 511;
        const float* hf = hT + (size_t)(o * 1024 + c) * SEQ; const float* hb = hT + (size_t)(o * 1024 + 512 + c) * SEQ;
        const float4 a4 = *(const float4*)(hf + F.tid * 4), b4 = *(const float4*)(hb + F.tid * 4);
        float ss = a4.x * a4.x + a4.y * a4.y + a4.z * a4.z + a4.w * a4.w + b4.x * b4.x + b4.y * b4.y + b4.z * b4.z + b4.w * b4.w;
        ss = wave_sum(ss);
        __syncthreads();
        if (F.lane == 0) red[F.wave] = ss;
        __syncthreads();
        float tot = 0.f;
        for (int w = 0; w < NWV; ++w) tot += red[w];
        const float rn = rsqrtf(tot + EPSF);
        bf16_t* GRc = ((bf16_t*)(F.a->ws + WS_GR)) + (size_t)(o * 512 + c) * 4096;
        const float av[4] = {a4.x, a4.y, a4.z, a4.w}, bv[4] = {b4.x, b4.y, b4.z, b4.w};
#pragma unroll
        for (int j = 0; j < 4; ++j) { const int d = 4 * F.tid + j; GRc[2048 - d] = f2bf(av[j] * rn); if (d >= 1) GRc[2048 + d] = f2bf(bv[j] * rn); }
        if (F.tid == 0) GRc[0] = 0;
    }
}

DI void ph_normmod(Frame& F, const float* src0, const float* src1, int nrows, const float* g, int shift_chunk, int scale_chunk, bf16_t* out) {
    const int lane = F.lane;
    for (int ch = F.bid * NWV + F.wave; ch < nrows / 4; ch += F.G * NWV) {
        const int row0 = ch * 4;
        const float* xr; int mrow;
        if (row0 < NTOK) { xr = src0 + (size_t)row0 * DM; mrow = row0 / SEQ; } else { xr = src1 + (size_t)(row0 - NTOK) * DM; mrow = NB; }
        const float* sh = ((float*)(F.a->ws + WS_MOD)) + (size_t)mrow * (6 * DM) + shift_chunk * DM;
        const float* sc = ((float*)(F.a->ws + WS_MOD)) + (size_t)mrow * (6 * DM) + scale_chunk * DM;
        float4 v[4][4];
#pragma unroll
        for (int r = 0; r < 4; ++r)
#pragma unroll
            for (int j = 0; j < 4; ++j) v[r][j] = *(const float4*)(xr + (size_t)r * DM + j * 256 + lane * 4);
        float4 mg[4], ms[4];
#pragma unroll
        for (int j = 0; j < 4; ++j) { const int c0 = j * 256 + lane * 4; const float4 g4 = *(const float4*)(g + c0), s4 = *(const float4*)(sc + c0); ms[j] = *(const float4*)(sh + c0);
            mg[j] = make_float4(g4.x * (1.f + s4.x), g4.y * (1.f + s4.y), g4.z * (1.f + s4.z), g4.w * (1.f + s4.w)); }
#pragma unroll
        for (int r = 0; r < 4; ++r) {
            float ss = 0.f;
#pragma unroll
            for (int j = 0; j < 4; ++j) ss += v[r][j].x * v[r][j].x + v[r][j].y * v[r][j].y + v[r][j].z * v[r][j].z + v[r][j].w * v[r][j].w;
            ss = wave_sum(ss);
            const float rstd = rsqrtf(ss * (1.f / DM) + EPSF);
#pragma unroll
            for (int j = 0; j < 4; ++j) {
                const int c0 = j * 256 + lane * 4;
                uint2 pk; pk.x = pk2(v[r][j].x * rstd * mg[j].x + ms[j].x, v[r][j].y * rstd * mg[j].y + ms[j].y); pk.y = pk2(v[r][j].z * rstd * mg[j].z + ms[j].z, v[r][j].w * rstd * mg[j].w + ms[j].w);
                *(uint2*)(out + (size_t)(row0 + r) * DM + c0) = pk;
            }
        }
    }
}


DI void ph_normmod_b(Frame& F, const bf16_t* src, const float* g, int shift_chunk, int scale_chunk, bf16_t* out, int row_lo, int row_hi) {
    const int lane = F.lane, mrow = row_lo / SEQ;
    const float* sh = ((const float*)(F.a->ws + WS_MOD)) + (size_t)mrow * (6 * DM) + shift_chunk * DM + lane * 4;
    const float* sc = ((const float*)(F.a->ws + WS_MOD)) + (size_t)mrow * (6 * DM) + scale_chunk * DM + lane * 4;
    float mg[16], ms[16];
#pragma unroll
    for (int k = 0; k < 4; ++k) { const float4 g4 = *(const float4*)(g + lane * 4 + 256 * k), s4 = *(const float4*)(sc + 256 * k), h4 = *(const float4*)(sh + 256 * k);
        mg[4 * k] = g4.x * (1.f + s4.x); mg[4 * k + 1] = g4.y * (1.f + s4.y); mg[4 * k + 2] = g4.z * (1.f + s4.z); mg[4 * k + 3] = g4.w * (1.f + s4.w);
        ms[4 * k] = h4.x; ms[4 * k + 1] = h4.y; ms[4 * k + 2] = h4.z; ms[4 * k + 3] = h4.w; }
    for (int ch = row_lo / 4 + F.wave; ch < row_hi / 4; ch += NWV) {
        const int row0 = ch * 4;
        uint2 v[4][4];
#pragma unroll
        for (int r = 0; r < 4; ++r)
#pragma unroll
            for (int k = 0; k < 4; ++k) v[r][k] = *(const uint2*)(src + (size_t)(row0 + r) * DM + lane * 4 + 256 * k);
#pragma unroll
        for (int r = 0; r < 4; ++r) {
            float f[16]; float ss = 0.f;
#pragma unroll
            for (int k = 0; k < 4; ++k) { f[4 * k] = __uint_as_float(v[r][k].x << 16); f[4 * k + 1] = __uint_as_float(v[r][k].x & 0xffff0000u); f[4 * k + 2] = __uint_as_float(v[r][k].y << 16); f[4 * k + 3] = __uint_as_float(v[r][k].y & 0xffff0000u); }
#pragma unroll
            for (int i = 0; i < 16; ++i) ss += f[i] * f[i];
            ss = wave_sum(ss);
            const float rstd = rsqrtf(ss * (1.f / DM) + EPSF);
#pragma unroll
            for (int k = 0; k < 4; ++k) {
                uint2 o; o.x = pk2(f[4 * k] * rstd * mg[4 * k] + ms[4 * k], f[4 * k + 1] * rstd * mg[4 * k + 1] + ms[4 * k + 1]); o.y = pk2(f[4 * k + 2] * rstd * mg[4 * k + 2] + ms[4 * k + 2], f[4 * k + 3] * rstd * mg[4 * k + 3] + ms[4 * k + 3]);
                *(uint2*)(out + (size_t)(row0 + r) * DM + lane * 4 + 256 * k) = o;
            }
        }
    }
}

struct EpiPx { bf16_t* out; const float* bias; int ldc; DI void operator()(int r, int c, float a) const { out[(size_t)r * ldc + c] = f2bf(a + bias[c]); } };
struct EpiGlu { bf16_t* out; const bf16_t* gy; const float* bias; DI void operator()(int r, int c, float a) const { const float gyv = bf2f(gy[(size_t)r * S5W + c]); out[(size_t)r * S5W + c] = f2bf(gyv * sigmoid_f(a + bias[c])); } };
struct EpiRes { float* out; const float* x; const float* mod; DI void operator()(int r, int c, float a) const { const int b = r / SEQ; out[(size_t)r * DM + c] = x[(size_t)r * DM + c] + mod[(size_t)b * (6 * DM) + 2 * DM + c] * a; } };
struct EpiQ { bf16_t* out; DI void operator()(int r, int c, float a) const { out[(size_t)r * PROJ + c] = f2bf(a); } };

template <class Epi>
DI void ph_gemm(Frame& F, const bf16_t* A, int lda, const float* B, int ldb, int M, int N, int K, const Epi& epi, int item0, int nitems_total) {
    float (*As)[132] = (float (*)[132])F.lds;
    float (*Bs)[64] = (float (*)[64])(F.lds + 16 * 132 * 4);
    const int tid = F.tid, tx = tid & 15, ty = tid >> 4;
    const int nn = N / 64, nit = (M / 128) * nn;
    const int ar = tid >> 2, ak = (tid & 3) * 4;
    const int bk = (tid & 255) >> 4, bn = (tid & 15) * 4;
    for (int itg = F.bid; itg < nitems_total; itg += F.G) {
        const int it = itg - item0;
        if (it < 0 || it >= nit) continue;
        const int m0 = (it / nn) * 128, n0 = (it % nn) * 64;
        float acc[4][4];
#pragma unroll
        for (int i = 0; i < 4; ++i)
#pragma unroll
            for (int j = 0; j < 4; ++j) acc[i][j] = 0.f;
        for (int k0 = 0; k0 < K; k0 += 16) {
            const uint2 av = *(const uint2*)(A + (size_t)(m0 + ar) * lda + k0 + ak);
            float4 bv = {0.f, 0.f, 0.f, 0.f};
            if (tid < 256) bv = *(const float4*)(B + (size_t)(k0 + bk) * ldb + n0 + bn);
            __syncthreads();
            As[ak + 0][ar] = __uint_as_float(av.x << 16); As[ak + 1][ar] = __uint_as_float(av.x & 0xffff0000u);
            As[ak + 2][ar] = __uint_as_float(av.y << 16); As[ak + 3][ar] = __uint_as_float(av.y & 0xffff0000u);
            if (tid < 256) *(float4*)&Bs[bk][bn] = bv;
            __syncthreads();
#pragma unroll
            for (int kk = 0; kk < 16; ++kk) {
                const float4 a4 = *(const float4*)&As[kk][ty * 4];
                const float4 b4 = *(const float4*)&Bs[kk][tx * 4];
                const float a[4] = {a4.x, a4.y, a4.z, a4.w}, b[4] = {b4.x, b4.y, b4.z, b4.w};
#pragma unroll
                for (int i = 0; i < 4; ++i)
#pragma unroll
                    for (int j = 0; j < 4; ++j) acc[i][j] += a[i] * b[j];
            }
        }
#pragma unroll
        for (int i = 0; i < 4; ++i)
#pragma unroll
            for (int j = 0; j < 4; ++j) epi(m0 + ty * 4 + i, n0 + tx * 4 + j, acc[i][j]);
        __syncthreads();
    }
}

DI void ph_s5scan(Frame& F) {
    const int p = F.lane;
    if (F.wave < 4) {
        for (int idx = F.bid * 4 + F.wave; idx < NB * S5G; idx += F.G * 4) {
            const int b = idx >> 5, g = idx & 31;
            for (int dr = 0; dr < 2; ++dr) {
                const int dg = dr * S5G + g;
                const float lr = ((float*)(F.a->ws + WS_LAM))[(dg * S5P + p) * 2], li = ((float*)(F.a->ws + WS_LAM))[(dg * S5P + p) * 2 + 1];
                float br[S5H], bi[S5H], cr[S5H], ci[S5H];
#pragma unroll
                for (int h = 0; h < S5H; ++h) {
                    br[h] = ((float*)(F.a->ws + WS_BB))[((size_t)(dg * S5P + p) * S5H + h) * 2]; bi[h] = ((float*)(F.a->ws + WS_BB))[((size_t)(dg * S5P + p) * S5H + h) * 2 + 1];
                    cr[h] = (F.a->in[15])[((size_t)dg * S5H + h) * S5P + p]; ci[h] = (F.a->in[16])[((size_t)dg * S5H + h) * S5P + p];
                }
                const float dv = (p < S5H) ? (F.a->in[17])[g * S5H + p] : 0.f;
                float sr = 0.f, si = 0.f;
                for (int i = 0; i < LC; ++i) {
                    const int t = dr == 0 ? i : LC - 1 - i;
                    const bf16_t* up = ((bf16_t*)(F.a->ws + WS_PC)) + (size_t)(b * LC + t) * S5W + g * S5H;
                    const uint4 u0 = *(const uint4*)up, u1 = *(const uint4*)(up + 8);
                    const unsigned uw[8] = {u0.x, u0.y, u0.z, u0.w, u1.x, u1.y, u1.z, u1.w};
                    float ur = 0.f, ui = 0.f;
#pragma unroll
                    for (int h = 0; h < S5H; ++h) { const float u = (h & 1) ? __uint_as_float(uw[h >> 1] & 0xffff0000u) : __uint_as_float(uw[h >> 1] << 16); ur += br[h] * u; ui += bi[h] * u; }
                    const float nr = lr * sr - li * si + ur, ni = lr * si + li * sr + ui;
                    sr = nr; si = ni;
                }
                for (int i = 0; i < SEQ; ++i) {
                    const int t = dr == 0 ? i : SEQ - 1 - i;
                    const size_t tok = (size_t)b * SEQ + t;
                    const bf16_t* up = ((bf16_t*)(F.a->ws + WS_R2)) + tok * PROJ + g * S5H;
                    const uint4 u0 = *(const uint4*)up, u1 = *(const uint4*)(up + 8);
                    const unsigned uw[8] = {u0.x, u0.y, u0.z, u0.w, u1.x, u1.y, u1.z, u1.w};
                    float ur = 0.f, ui = 0.f;
#pragma unroll
                    for (int h = 0; h < S5H; ++h) { const float u = (h & 1) ? __uint_as_float(uw[h >> 1] & 0xffff0000u) : __uint_as_float(uw[h >> 1] << 16); ur += br[h] * u; ui += bi[h] * u; }
                    const float nr = lr * sr - li * si + ur, ni = lr * si + li * sr + ui;
                    sr = nr; si = ni;
                    float mine = 0.f;
#pragma unroll
                    for (int h = 0; h < S5H; ++h) { const float v = wave_sum(cr[h] * sr - ci[h] * si); if (p == h) mine = v; }
                    if (p < S5H) {
                        if (dr == 0) { const float u = bf2f(up[p]); ((float*)(F.a->ws + WS_R1))[tok * S5W + g * S5H + p] = dv * u + mine; }
                        else { const float y = ((float*)(F.a->ws + WS_R1))[tok * S5W + g * S5H + p] + mine; ((bf16_t*)(F.a->ws + WS_GY))[tok * S5W + g * S5H + p] = f2bf(gelu_f(y)); }
                    }
                }
            }
        }
    }
}

DI void ph_shortconv(Frame& F) {
    unsigned char* tile = F.lds + F.wave * 18432; unsigned char* otile = tile + 9216;
    const int lane = F.lane, lr = lane >> 3, lp = lane & 7;
    const bf16_t* px = (const bf16_t*)(F.a->ws + WS_R2); bf16_t* qc = (bf16_t*)(F.a->ws + WS_R3);
    constexpr int NCT = HYC3 / 64, NIT = NCT * (SEQ / GRIDW) * NB;
    const int gw = F.bid * NWV + F.wave, NGW = F.G * NWV;
    uint4 n0, n1, n2, n3, n4, n5, n6, n7;
    n0 = n1 = n2 = n3 = n4 = n5 = n6 = n7 = make_uint4(0u, 0u, 0u, 0u);
#define SC_FETCH(IT) { const int ct_ = (IT) % NCT, row_ = ((IT) / NCT) % 32, b_ = (IT) / (NCT * 32); \
        const bf16_t* sp = px + ((size_t)b_ * SEQ + row_ * GRIDW + lr) * PROJ + S5W + ct_ * 64 + lp * 8; \
        n0 = *(const uint4*)sp; n1 = *(const uint4*)(sp + (size_t)8 * PROJ); n2 = *(const uint4*)(sp + (size_t)16 * PROJ); n3 = *(const uint4*)(sp + (size_t)24 * PROJ); \
        n4 = *(const uint4*)(sp + (size_t)32 * PROJ); n5 = *(const uint4*)(sp + (size_t)40 * PROJ); n6 = *(const uint4*)(sp + (size_t)48 * PROJ); n7 = *(const uint4*)(sp + (size_t)56 * PROJ); }
    if (gw < NIT) SC_FETCH(gw)
#pragma unroll 1
    for (int it = gw; it < NIT; it += NGW) {
        const int ct = it % NCT, row = (it / NCT) % 32, b = it / (NCT * 32);
        const int ch0 = ct * 64, t0 = row * GRIDW;
        unsigned char* tw = tile + lr * 144 + lp * 16;
        *(uint4*)(tw) = n0; *(uint4*)(tw + 8 * 144) = n1; *(uint4*)(tw + 16 * 144) = n2; *(uint4*)(tw + 24 * 144) = n3;
        *(uint4*)(tw + 32 * 144) = n4; *(uint4*)(tw + 40 * 144) = n5; *(uint4*)(tw + 48 * 144) = n6; *(uint4*)(tw + 56 * 144) = n7;
        if (it + NGW < NIT) SC_FETCH(it + NGW)
        asm volatile("s_waitcnt lgkmcnt(0)" ::: "memory");
        const int ch = ch0 + lane;
        const float w0 = F.a->in[20][ch], w1 = F.a->in[20][HYC3 + ch], w2 = F.a->in[20][2 * HYC3 + ch], bb = F.a->in[21][ch];
        const bf16_t* col = (const bf16_t*)(tile + lane * 2);
        float xm = 0.f, x0 = bf2f(col[0]);
#pragma unroll
        for (int k = 0; k < 8; ++k) {
            float y[8];
#pragma unroll
            for (int j = 0; j < 8; ++j) {
                const int t = 8 * k + j;
                const float xp = t + 1 < 64 ? bf2f(col[(t + 1) * 72]) : 0.f;
                y[j] = bb + w0 * xm + w1 * x0 + w2 * xp;
                xm = x0; x0 = xp;
            }
            *(uint4*)(otile + lane * 144 + k * 16) = make_uint4(pk2(y[0], y[1]), pk2(y[2], y[3]), pk2(y[4], y[5]), pk2(y[6], y[7]));
        }
        asm volatile("s_waitcnt lgkmcnt(0)" ::: "memory");
#pragma unroll
        for (int k = 0; k < 8; ++k) { const int c = 8 * k + lr;
            *(uint4*)(qc + ((size_t)b * HYC3 + ch0 + c) * SEQ + t0 + 8 * lp) = *(const uint4*)(otile + c * 144 + lp * 16); }
    }
#undef SC_FETCH
}

DI void ph_longconv(Frame& F) {
    float* zs = (float*)F.lds;
    float* gs = zs + SEQ;
    const int tid = F.tid;
    const int t0 = tid * 4;
    for (int it = F.bid; it < HYW * NB; it += F.G) {
        const int c = it & 511, b = it >> 9;
        const bf16_t* vrow = ((bf16_t*)(F.a->ws + WS_R3)) + ((size_t)b * HYC3 + c) * SEQ;
        __syncthreads();
        for (int i = tid; i < SEQ; i += NT) zs[i] = bf2f(vrow[i]);
        for (int o = 0; o < 2; ++o) {
            __syncthreads();
            const float* Gc = ((float*)(F.a->ws + WS_G)) + (size_t)(o * 512 + c) * 4096;
            for (int i = tid; i < 4096; i += NT) gs[i] = Gc[i];
            if (tid < 16) gs[4096 + tid] = 0.f;
            __syncthreads();
            float acc[4] = {0.f, 0.f, 0.f, 0.f};
            for (int s0 = 0; s0 < SEQ; s0 += 8) {
                const float4 za = *(const float4*)&zs[s0], zb = *(const float4*)&zs[s0 + 4];
                const float z[8] = {za.x, za.y, za.z, za.w, zb.x, zb.y, zb.z, zb.w};
                const int base = t0 - s0 + 2048 - 7;
                float w[11];
#pragma unroll
                for (int k = 0; k < 11; ++k) w[k] = gs[base + k];
#pragma unroll
                for (int i = 0; i < 4; ++i)
#pragma unroll
                    for (int j = 0; j < 8; ++j) acc[i] += w[i - j + 7] * z[j];
            }
            const bf16_t* grow = ((bf16_t*)(F.a->ws + WS_R3)) + ((size_t)b * HYC3 + (o + 1) * HYW + c) * SEQ;
            const float dd = (F.a->in[29])[o * HYW + c];
            float r[4];
#pragma unroll
            for (int i = 0; i < 4; ++i) r[i] = bf2f(grow[t0 + i]) * (acc[i] + dd * zs[t0 + i]);
            __syncthreads();
            if (o == 0) {
#pragma unroll
                for (int i = 0; i < 4; ++i) zs[t0 + i] = r[i];
            } else {
                bf16_t* orow = ((bf16_t*)(F.a->ws + WS_Z3)) + ((size_t)b * HYW + c) * SEQ;
#pragma unroll
                for (int i = 0; i < 4; ++i) orow[t0 + i] = f2bf(r[i]);
            }
        }
    }
}

DI void ph_cat_s5(Frame& F, int row_lo, int row_hi) {
    const int lane = F.lane;
    const float4 ga = *(const float4*)(F.a->in[30] + lane * 8), gb = *(const float4*)(F.a->in[30] + lane * 8 + 4);
    for (int rowi = row_lo + F.wave; rowi < row_hi; rowi += NWV) {
        const size_t row = rowi;
        float v[8]; float ss = 0.f;
        const uint4 pk = *(const uint4*)(((const bf16_t*)(F.a->ws + WS_S5O)) + row * S5W + lane * 8);
        const unsigned w[4] = {pk.x, pk.y, pk.z, pk.w};
#pragma unroll
        for (int i = 0; i < 4; ++i) { v[2 * i] = __uint_as_float(w[i] << 16); v[2 * i + 1] = __uint_as_float(w[i] & 0xffff0000u); ss += v[2 * i] * v[2 * i] + v[2 * i + 1] * v[2 * i + 1]; }
        ss = wave_sum(ss);
        const float rstd = rsqrtf(ss * (1.f / S5W) + EPSF);
        *(uint4*)(((bf16_t*)(F.a->ws + WS_R1)) + row * DM + lane * 8) = make_uint4(pk2(v[0] * rstd * ga.x, v[1] * rstd * ga.y), pk2(v[2] * rstd * ga.z, v[3] * rstd * ga.w),
                                                                                   pk2(v[4] * rstd * gb.x, v[5] * rstd * gb.y), pk2(v[6] * rstd * gb.z, v[7] * rstd * gb.w));
    }
}
DI void ph_cat_hy(Frame& F, int it_lo, int it_hi, int it_step) {
    unsigned char* tile = F.lds + F.wave * 18432; unsigned char* otile = tile + 9216;
    float* part = (float*)(F.lds + NWV * 18432);
    const int lane = F.lane, lr = lane >> 3, lp = lane & 7, wv = F.wave;
    const bf16_t* z3 = (const bf16_t*)(F.a->ws + WS_Z3); bf16_t* cat = (bf16_t*)(F.a->ws + WS_R1);
    int par = 0;
    for (int it = it_lo; it < it_hi; it += it_step, par ^= 1) {
        const int tt = it & 31, b = it >> 5, t0 = tt * 64;
        const bf16_t* sp = z3 + ((size_t)b * HYW + wv * 64 + lr) * SEQ + t0 + lp * 8;
        const uint4 n0 = *(const uint4*)sp, n1 = *(const uint4*)(sp + (size_t)8 * SEQ), n2 = *(const uint4*)(sp + (size_t)16 * SEQ), n3 = *(const uint4*)(sp + (size_t)24 * SEQ),
                    n4 = *(const uint4*)(sp + (size_t)32 * SEQ), n5 = *(const uint4*)(sp + (size_t)40 * SEQ), n6 = *(const uint4*)(sp + (size_t)48 * SEQ), n7 = *(const uint4*)(sp + (size_t)56 * SEQ);
        unsigned char* tw = tile + lr * 144 + lp * 16;
        *(uint4*)(tw) = n0; *(uint4*)(tw + 8 * 144) = n1; *(uint4*)(tw + 16 * 144) = n2; *(uint4*)(tw + 24 * 144) = n3;
        *(uint4*)(tw + 32 * 144) = n4; *(uint4*)(tw + 40 * 144) = n5; *(uint4*)(tw + 48 * 144) = n6; *(uint4*)(tw + 56 * 144) = n7;
        asm volatile("s_waitcnt lgkmcnt(0)" ::: "memory");
        float v[64]; float ss = 0.f;
        const bf16_t* col = (const bf16_t*)(tile + lane * 2);
#pragma unroll
        for (int c = 0; c < 64; ++c) { v[c] = bf2f(col[c * 72]); ss += v[c] * v[c]; }
        float* pp = part + par * (NWV * 64);
        pp[wv * 64 + lane] = ss;
        __syncthreads();
        float tot = 0.f;
#pragma unroll
        for (int w = 0; w < NWV; ++w) tot += pp[w * 64 + lane];
        const float rstd = rsqrtf(tot * (1.f / HYW) + EPSF);
        const float* gp = F.a->in[31] + wv * 64;
#pragma unroll
        for (int k = 0; k < 8; ++k) {
            const float4 g0 = *(const float4*)(gp + 8 * k), g1 = *(const float4*)(gp + 8 * k + 4);
            *(uint4*)(otile + lane * 144 + k * 16) = make_uint4(pk2(v[8 * k] * rstd * g0.x, v[8 * k + 1] * rstd * g0.y), pk2(v[8 * k + 2] * rstd * g0.z, v[8 * k + 3] * rstd * g0.w),
                                                                pk2(v[8 * k + 4] * rstd * g1.x, v[8 * k + 5] * rstd * g1.y), pk2(v[8 * k + 6] * rstd * g1.z, v[8 * k + 7] * rstd * g1.w));
        }
        asm volatile("s_waitcnt lgkmcnt(0)" ::: "memory");
#pragma unroll
        for (int k = 0; k < 8; ++k) { const int t = 8 * k + lr;
            *(uint4*)(cat + ((size_t)b * SEQ + t0 + t) * DM + S5W + wv * 64 + lp * 8) = *(const uint4*)(otile + t * 144 + lp * 16); }
    }
}

DI void ph_topk(Frame& F) {
    float* qv = (float*)F.lds;
    float (*sc)[PNK] = (float (*)[PNK])(qv + PROJ);
    float (*tv)[PTK] = (float (*)[PTK])(qv + PROJ + 16 * PNK);
    int (*ti)[PTK] = (int (*)[PTK])(qv + PROJ + 16 * PNK + 256);
    float (*cand)[256] = (float (*)[256])(qv + PROJ + 16 * PNK + 512);
    const int tid = F.tid;
    for (int toki = F.bid; toki < NTOK; toki += F.G) {
        const size_t tok = toki;
        __syncthreads();
        for (int i = tid; i < PROJ; i += NT) qv[i] = bf2f(((bf16_t*)(F.a->ws + WS_R2))[tok * PROJ + i]);
        __syncthreads();
        for (int e = tid; e < 16 * PNK; e += NT) {
            const int list = e >> 7, n = e & 127, head = list >> 1, half = list & 1;
            const float* kr = (half ? (F.a->in[35]) : (F.a->in[34])) + ((size_t)head * PNK + n) * PDH;
            const float* qq = qv + list * PDH;
            float s = 0.f;
            for (int d = 0; d < PDH; d += 4) { const float4 kv = *(const float4*)(kr + d); s += qq[d] * kv.x + qq[d + 1] * kv.y + qq[d + 2] * kv.z + qq[d + 3] * kv.w; }
            sc[list][n] = s;
        }
        __syncthreads();
        if (tid < 16) {
            for (int r = 0; r < PTK; ++r) {
                float best = -INFINITY; int bi = 0;
                for (int n = 0; n < PNK; ++n) { const float v = sc[tid][n]; if (v > best) { best = v; bi = n; } }
                tv[tid][r] = best; ti[tid][r] = bi; sc[tid][bi] = -INFINITY;
            }
        }
        __syncthreads();
        for (int e = tid; e < PH * 256; e += NT) { const int h = e >> 8, ab = e & 255; cand[h][ab] = tv[2 * h][ab >> 4] + tv[2 * h + 1][ab & 15]; }
        __syncthreads();
        if (tid < PH) {
            const int h = tid;
            float m = -INFINITY;
            for (int r = 0; r < PTK; ++r) {
                float best = -INFINITY; int bi = 0;
                for (int n = 0; n < 256; ++n) { const float v = cand[h][n]; if (v > best) { best = v; bi = n; } }
                cand[h][bi] = -INFINITY;
                if (r == 0) m = best;
                ((int*)(F.a->ws + WS_R3))[tok * 128 + h * PTK + r] = ti[2 * h][bi >> 4] * PNK + ti[2 * h + 1][bi & 15];
                sc[h][r] = expf(best - m);
            }
            float den = 0.f;
            for (int r = 0; r < PTK; ++r) den += sc[h][r];
            for (int r = 0; r < PTK; ++r) ((float*)(F.a->ws + WS_TKG))[tok * 128 + h * PTK + r] = sc[h][r] / den;
        }
    }
}

DI void ph_gather(Frame& F) {
    float* coef = (float*)F.lds;
    int* eid = (int*)(coef + 128);
    float* red = coef + 256;
    const int tid = F.tid, wave = F.wave, lane = F.lane;
    for (int toki = F.bid; toki < NTOK; toki += F.G) {
        const size_t tok = toki; const int b = toki / SEQ;
        __syncthreads();
        if (tid < 128) eid[tid] = ((int*)(F.a->ws + WS_R3))[tok * 128 + tid];
        float h[16];
        {
            const uint4 a = *(const uint4*)(((bf16_t*)(F.a->ws + WS_R1)) + tok * DM + lane * 16), c = *(const uint4*)(((bf16_t*)(F.a->ws + WS_R1)) + tok * DM + lane * 16 + 8);
            const unsigned w[8] = {a.x, a.y, a.z, a.w, c.x, c.y, c.z, c.w};
#pragma unroll
            for (int i = 0; i < 8; ++i) { h[2 * i] = __uint_as_float(w[i] << 16); h[2 * i + 1] = __uint_as_float(w[i] & 0xffff0000u); }
        }
        __syncthreads();
        for (int k = wave * 16; k < wave * 16 + 16; ++k) {
            const float* ur = (F.a->in[36]) + (size_t)eid[k] * DM + lane * 16;
            float s = 0.f;
#pragma unroll
            for (int i = 0; i < 4; ++i) { const float4 u4 = *(const float4*)(ur + i * 4); s += u4.x * h[i * 4] + u4.y * h[i * 4 + 1] + u4.z * h[i * 4 + 2] + u4.w * h[i * 4 + 3]; }
            s = wave_sum(s);
            if (lane == 0) coef[k] = ((float*)(F.a->ws + WS_TKG))[tok * 128 + k] * gelu_f(s);
        }
        __syncthreads();
        float2 acc = {0.f, 0.f};
        for (int k = 0; k < 128; ++k) {
            const float2 v2 = *(const float2*)((F.a->in[37]) + (size_t)eid[k] * DM + tid * 2);
            const float cf = coef[k];
            acc.x += cf * v2.x; acc.y += cf * v2.y;
        }
        const float* g2 = ((float*)(F.a->ws + WS_MOD)) + (size_t)b * (6 * DM) + 5 * DM + tid * 2;
        float2 xv = *(const float2*)((F.a->out) + tok * DM + tid * 2);
        xv.x += g2[0] * acc.x; xv.y += g2[1] * acc.y;
        const float ss = wave_sum(xv.x * xv.x + xv.y * xv.y);
        if (lane == 0) red[wave] = ss;
        __syncthreads();
        float tot = 0.f;
        for (int w = 0; w < NWV; ++w) tot += red[w];
        const float rstd = rsqrtf(tot * (1.f / DM) + EPSF);
        const float* gf = (F.a->in[38]) + tid * 2;
        float2 o; o.x = xv.x * rstd * gf[0]; o.y = xv.y * rstd * gf[1];
        *(float2*)((F.a->out) + tok * DM + tid * 2) = o;
    }
}


typedef float f32x2_t __attribute__((ext_vector_type(2)));
typedef _Float16 h2_t __attribute__((ext_vector_type(2)));
DI void ph_tabprep(Frame& F) {
    const int lane = F.lane;
    for (int r = F.bid * NWV + F.wave; r < 2 * 16384; r += F.G * NWV) {
        const int tab = r >> 14, row = r & 16383;
        const float* src = (tab ? F.a->in[37] : F.a->in[36]) + (size_t)row * DM + lane * 16;
        float v[16];
#pragma unroll
        for (int j = 0; j < 4; ++j) { const float4 t = *(const float4*)(src + 4 * j); v[4 * j] = t.x; v[4 * j + 1] = t.y; v[4 * j + 2] = t.z; v[4 * j + 3] = t.w; }
        float m = 0.f;
#pragma unroll
        for (int j = 0; j < 16; ++j) m = fmaxf(m, fabsf(v[j]));
#pragma unroll
        for (int o = 1; o < 64; o <<= 1) m = fmaxf(m, __shfl_xor(m, o));
        const float sc = m > 0.f ? m * (1.f / 440.f) : 1.f, inv = 1.f / sc;
        uint4 o4; int w;
        w = __builtin_amdgcn_cvt_pk_fp8_f32(v[0] * inv, v[1] * inv, 0, false); w = __builtin_amdgcn_cvt_pk_fp8_f32(v[2] * inv, v[3] * inv, w, true); o4.x = (unsigned)w;
        w = __builtin_amdgcn_cvt_pk_fp8_f32(v[4] * inv, v[5] * inv, 0, false); w = __builtin_amdgcn_cvt_pk_fp8_f32(v[6] * inv, v[7] * inv, w, true); o4.y = (unsigned)w;
        w = __builtin_amdgcn_cvt_pk_fp8_f32(v[8] * inv, v[9] * inv, 0, false); w = __builtin_amdgcn_cvt_pk_fp8_f32(v[10] * inv, v[11] * inv, w, true); o4.z = (unsigned)w;
        w = __builtin_amdgcn_cvt_pk_fp8_f32(v[12] * inv, v[13] * inv, 0, false); w = __builtin_amdgcn_cvt_pk_fp8_f32(v[14] * inv, v[15] * inv, w, true); o4.w = (unsigned)w;
        *(uint4*)(F.a->ws + (tab ? WS_V8 : WS_U8) + (size_t)row * DM + lane * 16) = o4;
        if (lane == 0) ((float*)(F.a->ws + (tab ? WS_SV : WS_SU)))[row] = sc;
    }
}

DI void dec16(const uint4& r, float (&f)[16]) {
    const int w[4] = {(int)r.x, (int)r.y, (int)r.z, (int)r.w};
#pragma unroll
    for (int i = 0; i < 4; ++i) { const f32x2_t a = __builtin_amdgcn_cvt_pk_f32_fp8(w[i], false), b = __builtin_amdgcn_cvt_pk_f32_fp8(w[i], true); f[4 * i] = a.x; f[4 * i + 1] = a.y; f[4 * i + 2] = b.x; f[4 * i + 3] = b.y; }
}
DI float dot16(const uint4& r, const f32x2_t (&h2)[8]) {
    const int w[4] = {(int)r.x, (int)r.y, (int)r.z, (int)r.w};
    f32x2_t s2 = {0.f, 0.f};
#pragma unroll
    for (int i = 0; i < 4; ++i) { s2 += __builtin_amdgcn_cvt_pk_f32_fp8(w[i], false) * h2[2 * i]; s2 += __builtin_amdgcn_cvt_pk_f32_fp8(w[i], true) * h2[2 * i + 1]; }
    return s2.x + s2.y;
}
DI void axpy16(const uint4& r, float c, f32x2_t (&acc2)[8]) {
    const int w[4] = {(int)r.x, (int)r.y, (int)r.z, (int)r.w};
    const f32x2_t c2 = {c, c};
#pragma unroll
    for (int i = 0; i < 4; ++i) { acc2[2 * i] += c2 * __builtin_amdgcn_cvt_pk_f32_fp8(w[i], false); acc2[2 * i + 1] += c2 * __builtin_amdgcn_cvt_pk_f32_fp8(w[i], true); }
}
DI float reduce16(const float (&v)[16], int lane) {
    const bool b5 = (lane & 32) != 0, b4 = (lane & 16) != 0, b3 = (lane & 8) != 0, b2 = (lane & 4) != 0;
    float a[8], b[4], c[2];
#pragma unroll
    for (int j = 0; j < 8; ++j) { const float send = b5 ? v[j] : v[j + 8], keep = b5 ? v[j + 8] : v[j]; a[j] = keep + __shfl_xor(send, 32); }
#pragma unroll
    for (int j = 0; j < 4; ++j) { const float send = b4 ? a[j] : a[j + 4], keep = b4 ? a[j + 4] : a[j]; b[j] = keep + __shfl_xor(send, 16); }
#pragma unroll
    for (int j = 0; j < 2; ++j) { const float send = b3 ? b[j] : b[j + 2], keep = b3 ? b[j + 2] : b[j]; c[j] = keep + __shfl_xor(send, 8); }
    const float send = b2 ? c[0] : c[1], keep = b2 ? c[1] : c[0];
    float x = keep + __shfl_xor(send, 4);
    x += __shfl_xor(x, 1); x += __shfl_xor(x, 2);
    return x;
}
DI void ph_gather8(Frame& F) {
    const int lane = F.lane;
    const unsigned char* u8 = F.a->ws + WS_U8 + lane * 16;
    const unsigned char* v8 = F.a->ws + WS_V8 + lane * 16;
    const float* su = (const float*)(F.a->ws + WS_SU); const float* sv = (const float*)(F.a->ws + WS_SV);
    const int* tke = (const int*)(F.a->ws + WS_R3); const float* tkg = (const float*)(F.a->ws + WS_TKG);
    const bf16_t* hx2 = (const bf16_t*)(F.a->ws + WS_R1);
    for (int toki = F.bid * NWV + F.wave; toki < NTOK; toki += F.G * NWV) {
        const size_t tok = toki; const int b = toki / SEQ;
        int ev[2]; float cv[2];
        f32x2_t h2[8];
        {
            const uint4 a = *(const uint4*)(hx2 + tok * DM + lane * 16), c = *(const uint4*)(hx2 + tok * DM + lane * 16 + 8);
            const unsigned w[8] = {a.x, a.y, a.z, a.w, c.x, c.y, c.z, c.w};
#pragma unroll
            for (int i = 0; i < 8; ++i) { h2[i].x = __uint_as_float(w[i] << 16); h2[i].y = __uint_as_float(w[i] & 0xffff0000u); }
        }
#pragma unroll
        for (int half = 0; half < 2; ++half) {
            ev[half] = tke[tok * 128 + half * 64 + lane];
            const float gvv = tkg[tok * 128 + half * 64 + lane];
            const float sue = su[ev[half]], sve = sv[ev[half]];
            float cvh = 0.f;
            uint4 bufA[8], bufB[8];
#pragma unroll
            for (int kk = 0; kk < 8; ++kk) { const int e = __builtin_amdgcn_readlane(ev[half], kk); bufA[kk] = *(const uint4*)(u8 + (size_t)e * DM); }
#pragma unroll 1
            for (int bb = 0; bb < 4; ++bb) {
                float part[16];
#pragma unroll
                for (int kk = 0; kk < 8; ++kk) { const int e = __builtin_amdgcn_readlane(ev[half], bb * 16 + 8 + kk); bufB[kk] = *(const uint4*)(u8 + (size_t)e * DM); }
#pragma unroll
                for (int kk = 0; kk < 8; ++kk) part[kk] = dot16(bufA[kk], h2);
                if (bb < 3) {
#pragma unroll
                    for (int kk = 0; kk < 8; ++kk) { const int e = __builtin_amdgcn_readlane(ev[half], bb * 16 + 16 + kk); bufA[kk] = *(const uint4*)(u8 + (size_t)e * DM); }
                }
#pragma unroll
                for (int kk = 0; kk < 8; ++kk) part[8 + kk] = dot16(bufB[kk], h2);
                const float t2 = __shfl(reduce16(part, lane), (lane & 15) << 2);
                const float c = gvv * gelu_f(t2 * sue) * sve;
                cvh = ((lane >> 4) == bb) ? c : cvh;
            }
            cv[half] = cvh;
        }
        f32x2_t acc2[8];
#pragma unroll
        for (int j = 0; j < 8; ++j) acc2[j] = (f32x2_t){0.f, 0.f};
#pragma unroll
        for (int half = 0; half < 2; ++half) {
            uint4 bufA[8], bufB[8];
#pragma unroll
            for (int kk = 0; kk < 8; ++kk) { const int e = __builtin_amdgcn_readlane(ev[half], kk); bufA[kk] = *(const uint4*)(v8 + (size_t)e * DM); }
#pragma unroll 1
            for (int bb = 0; bb < 4; ++bb) {
#pragma unroll
                for (int kk = 0; kk < 8; ++kk) { const int e = __builtin_amdgcn_readlane(ev[half], bb * 16 + 8 + kk); bufB[kk] = *(const uint4*)(v8 + (size_t)e * DM); }
#pragma unroll
                for (int kk = 0; kk < 8; ++kk) { const float c = __builtin_bit_cast(float, __builtin_amdgcn_readlane(__builtin_bit_cast(int, cv[half]), bb * 16 + kk)); axpy16(bufA[kk], c, acc2); }
                if (bb < 3) {
#pragma unroll
                    for (int kk = 0; kk < 8; ++kk) { const int e = __builtin_amdgcn_readlane(ev[half], bb * 16 + 16 + kk); bufA[kk] = *(const uint4*)(v8 + (size_t)e * DM); }
                }
#pragma unroll
                for (int kk = 0; kk < 8; ++kk) { const float c = __builtin_bit_cast(float, __builtin_amdgcn_readlane(__builtin_bit_cast(int, cv[half]), bb * 16 + 8 + kk)); axpy16(bufB[kk], c, acc2); }
            }
        }
        const float* g2 = (const float*)(F.a->ws + WS_MOD) + (size_t)b * (6 * DM) + 5 * DM + lane * 16;
        float* xr = F.a->out + tok * DM + lane * 16;
        const float* gf = F.a->in[38] + lane * 16;
        float acc[16];
#pragma unroll
        for (int j = 0; j < 8; ++j) { acc[2 * j] = acc2[j].x; acc[2 * j + 1] = acc2[j].y; }
        float xv[16]; float ss = 0.f;
#pragma unroll
        for (int j = 0; j < 4; ++j) {
            const float4 x4 = *(const float4*)(xr + 4 * j), g4 = *(const float4*)(g2 + 4 * j);
            xv[4 * j] = x4.x + g4.x * acc[4 * j]; xv[4 * j + 1] = x4.y + g4.y * acc[4 * j + 1]; xv[4 * j + 2] = x4.z + g4.z * acc[4 * j + 2]; xv[4 * j + 3] = x4.w + g4.w * acc[4 * j + 3];
            ss += xv[4 * j] * xv[4 * j] + xv[4 * j + 1] * xv[4 * j + 1] + xv[4 * j + 2] * xv[4 * j + 2] + xv[4 * j + 3] * xv[4 * j + 3];
        }
        ss = wave_sum(ss);
        const float rstd = rsqrtf(ss * (1.f / DM) + EPSF);
#pragma unroll
        for (int j = 0; j < 4; ++j) {
            const float4 f4 = *(const float4*)(gf + 4 * j);
            float4 o; o.x = xv[4 * j] * rstd * f4.x; o.y = xv[4 * j + 1] * rstd * f4.y; o.z = xv[4 * j + 2] * rstd * f4.z; o.w = xv[4 * j + 3] * rstd * f4.w;
            *(float4*)(xr + 4 * j) = o;
        }
    }
}


DI void ph_keyprep(Frame& F) {
    bf16_t* kb = (bf16_t*)(F.a->ws + WS_KB);
    for (int i = F.bid * NT + F.tid; i < 16 * PNK * PDH; i += F.G * NT) {
        const int list = i >> 14, rem = i & 16383, head = list >> 1;
        kb[i] = f2bf(((list & 1) ? F.a->in[35] : F.a->in[34])[(size_t)head * (PNK * PDH) + rem]);
    }
}

typedef short bf16x8_t __attribute__((ext_vector_type(8)));
typedef float f32x16_t __attribute__((ext_vector_type(16)));
DI void ce_desc(float& x, float& y) { float hi, lo; asm("v_max_f32 %0, %1, %2" : "=v"(hi) : "v"(x), "v"(y)); asm("v_min_f32 %0, %1, %2" : "=v"(lo) : "v"(x), "v"(y)); x = hi; y = lo; }
DI float fmax_raw(float x, float y) { float hi; asm("v_max_f32 %0, %1, %2" : "=v"(hi) : "v"(x), "v"(y)); return hi; }
DI void sort16_desc(float (&a)[16]) {
#define CE(i, j) ce_desc(a[i], a[j]);
    CE(0,1) CE(2,3) CE(0,2) CE(1,3) CE(1,2) CE(4,5) CE(6,7) CE(4,6) CE(5,7) CE(5,6) CE(0,4) CE(2,6) CE(2,4) CE(1,5) CE(3,7) CE(3,5) CE(1,2) CE(3,4) CE(5,6) CE(8,9) CE(10,11) CE(8,10) CE(9,11) CE(9,10) CE(12,13) CE(14,15) CE(12,14) CE(13,15) CE(13,14) CE(8,12) CE(10,14) CE(10,12) CE(9,13) CE(11,15) CE(11,13) CE(9,10) CE(11,12) CE(13,14) CE(0,8) CE(4,12) CE(4,8) CE(2,10) CE(6,14) CE(6,10) CE(2,4) CE(6,8) CE(10,12) CE(1,9) CE(5,13) CE(5,9) CE(3,11) CE(7,15) CE(7,11) CE(3,5) CE(7,9) CE(11,13) CE(1,2) CE(3,4) CE(5,6) CE(7,8) CE(9,10) CE(11,12) CE(13,14)
#undef CE
}
DI void bmerge16_desc(float (&a)[16]) {
#pragma unroll
    for (int j = 8; j > 0; j >>= 1)
#pragma unroll
        for (int i = 0; i < 16; ++i) { const int l = i ^ j; if (l > i) ce_desc(a[i], a[l]); }
}
DI void merge16(float (&a)[16], const float (&b)[16]) {
#pragma unroll
    for (int i = 0; i < 16; ++i) a[i] = fmax_raw(a[i], b[15 - i]);
    bmerge16_desc(a);
}
DI void ph_topk2(Frame& F) {
    const int lane = F.lane, c = lane & 31, h = lane >> 5;
    const bf16_t* q = (const bf16_t*)(F.a->ws + WS_R2);
    const bf16_t* kb = (const bf16_t*)(F.a->ws + WS_KB);
    int* tke = (int*)(F.a->ws + WS_R3); float* tkg = (float*)(F.a->ws + WS_TKG);
    constexpr int KIMG = 2 * PNK * 272;
    unsigned char* ixl = F.lds + 2 * KIMG + F.wave * 2048 + c * 48;
    const int tid = F.tid;
    for (int tt0 = F.bid * NWV; tt0 < NTOK / 32; tt0 += F.G * NWV) {
        const int tt = tt0 + F.wave;
        const size_t tok = (size_t)tt * 32 + c;
        const bf16_t* qrow = q + tok * PROJ + 8 * h;
#define KLD(p, hd) kst##p = *(const uint4*)((const unsigned char*)kb + (ktofs + (unsigned)(p) * 8192u + (unsigned)(hd) * 65536u));
#define KST(p, bf) *(uint4*)(F.lds + (bf) * KIMG + ((tid + p * NT) >> 4) * 272 + ((tid + p * NT) & 15) * 16) = kst##p;
        uint4 kst0, kst1, kst2, kst3, kst4, kst5, kst6, kst7;
        const unsigned ktofs = (unsigned)(tid >> 4) * 256u + (unsigned)(tid & 15) * 16u;
        KLD(0, 0) KLD(1, 0) KLD(2, 0) KLD(3, 0) KLD(4, 0) KLD(5, 0) KLD(6, 0) KLD(7, 0)
        __syncthreads();
        KST(0, 0) KST(1, 0) KST(2, 0) KST(3, 0) KST(4, 0) KST(5, 0) KST(6, 0) KST(7, 0)
        __syncthreads();
#pragma unroll 1
        for (int head = 0; head < PH; ++head) {
            float vv[2][16];
            const unsigned char* kimg = F.lds + (head & 1) * KIMG;
            bf16x8_t bqn[8];
#pragma unroll
            for (int ks = 0; ks < 8; ++ks) bqn[ks] = *(const bf16x8_t*)(qrow + (head * 2) * PDH + ks * 16);
#pragma unroll
            for (int half = 0; half < 2; ++half) {
                const int list = head * 2 + half;
                f32x16_t acc[4];
#pragma unroll
                for (int kt = 0; kt < 4; ++kt)
#pragma unroll
                    for (int i = 0; i < 16; ++i) acc[kt][i] = 0.f;
                const unsigned char* kl = kimg + (half * PNK + c) * 272 + 16 * h;
                bf16x8_t bq[8];
#pragma unroll
                for (int ks = 0; ks < 8; ++ks) bq[ks] = bqn[ks];
                if (half == 0) {
#pragma unroll
                    for (int ks = 0; ks < 8; ++ks) bqn[ks] = *(const bf16x8_t*)(qrow + (head * 2 + 1) * PDH + ks * 16);
                }
#pragma unroll
                for (int ks = 0; ks < 8; ++ks) {
#pragma unroll
                    for (int kt = 0; kt < 4; ++kt) {
                        const bf16x8_t ak = *(const bf16x8_t*)(kl + kt * 32 * 272 + ks * 32);
                        acc[kt] = __builtin_amdgcn_mfma_f32_32x32x16_bf16(ak, bq[ks], acc[kt], 0, 0, 0);
                    }
                }
                float g[4][16];
#pragma unroll
                for (int kt = 0; kt < 4; ++kt)
#pragma unroll
                    for (int i = 0; i < 16; ++i) { const unsigned u = (__float_as_uint(acc[kt][i]) & 0xFFFFFF84u) | (unsigned)(kt * 32 + (i & 3) + 8 * (i >> 2)); g[kt][i] = __uint_as_float(u); }
#pragma unroll
                for (int kt = 0; kt < 4; ++kt) sort16_desc(g[kt]);
                merge16(g[0], g[1]); merge16(g[2], g[3]); merge16(g[0], g[2]);
                float other[16];
#pragma unroll
                for (int i = 0; i < 16; ++i) { g[0][i] = __uint_as_float((__float_as_uint(g[0][i]) & 0xFFFFFFFBu) | (unsigned)(4 * h)); other[i] = __shfl_xor(g[0][i], 32); }
                merge16(g[0], other);
#pragma unroll
                for (int i = 0; i < 16; ++i) vv[half][i] = g[0][i];
                unsigned pk[4];
#pragma unroll
                for (int w = 0; w < 4; ++w) pk[w] = (__float_as_uint(g[0][4 * w]) & 127u) | ((__float_as_uint(g[0][4 * w + 1]) & 127u) << 8) | ((__float_as_uint(g[0][4 * w + 2]) & 127u) << 16) | ((__float_as_uint(g[0][4 * w + 3]) & 127u) << 24);
                if (h == 0) { uint4 o; o.x = pk[0]; o.y = pk[1]; o.z = pk[2]; o.w = pk[3]; *(uint4*)(ixl + half * 16) = o; }
            }
            if (head + 1 < PH) { KLD(0, head + 1) KLD(1, head + 1) KLD(2, head + 1) KLD(3, head + 1) KLD(4, head + 1) KLD(5, head + 1) KLD(6, head + 1) KLD(7, head + 1) }
            const float SENT = -3.0e38f;
            float G0[16], G1[16], G2[16], G3[16];
#define CAND(a, b) __uint_as_float((__float_as_uint(vv[0][a] + vv[1][b]) & 0xFFFFFF00u) | (unsigned)((a) * 16 + (b)))
#pragma unroll
            for (int b2 = 0; b2 < 16; ++b2) G0[b2] = CAND(0, b2);
#pragma unroll
            for (int b2 = 0; b2 < 8; ++b2) G1[b2] = CAND(1, b2);
#pragma unroll
            for (int a2 = 8; a2 < 16; ++a2) G1[8 + (15 - a2)] = CAND(a2, 0);
            bmerge16_desc(G1);
            G2[0] = CAND(2, 0); G2[1] = CAND(2, 1); G2[2] = CAND(2, 2); G2[3] = CAND(2, 3); G2[4] = CAND(2, 4);
            G2[5] = CAND(3, 0); G2[6] = CAND(3, 1); G2[7] = CAND(3, 2); G2[8] = CAND(3, 3);
            G2[9] = CAND(4, 0); G2[10] = CAND(4, 1); G2[11] = CAND(4, 2);
            G2[12] = CAND(5, 0); G2[13] = CAND(5, 1); G2[14] = CAND(6, 0); G2[15] = CAND(6, 1);
            sort16_desc(G2);
            G3[0] = CAND(7, 0); G3[1] = CAND(7, 1);
#pragma unroll
            for (int i = 2; i < 16; ++i) G3[i] = SENT;
#undef CAND
            merge16(G0, G1); merge16(G2, G3); merge16(G0, G2);
            asm volatile("s_waitcnt lgkmcnt(0)" ::: "memory");
            int ee[16]; float ex[16]; float den = 0.f;
            const float m0 = __uint_as_float(__float_as_uint(G0[0]) & 0xFFFFFF00u);
#pragma unroll
            for (int r = 0; r < 16; ++r) {
                const unsigned u = __float_as_uint(G0[r]); const unsigned a2 = (u >> 4) & 15u, b2 = u & 15u;
                const int i1 = ixl[a2], i2 = ixl[16 + b2];
                ee[r] = i1 * PNK + i2;
                ex[r] = __expf(__uint_as_float(u & 0xFFFFFF00u) - m0); den += ex[r];
            }
            const float rden = 1.f / den;
            if (h == 0) {
                int* ep = tke + tok * 128 + head * PTK; float* gp = tkg + tok * 128 + head * PTK;
#pragma unroll
                for (int w = 0; w < 4; ++w) {
                    *(int4*)(ep + 4 * w) = make_int4(ee[4 * w], ee[4 * w + 1], ee[4 * w + 2], ee[4 * w + 3]);
                    *(float4*)(gp + 4 * w) = make_float4(ex[4 * w] * rden, ex[4 * w + 1] * rden, ex[4 * w + 2] * rden, ex[4 * w + 3] * rden);
                }
            }
            asm volatile("s_waitcnt lgkmcnt(0)" ::: "memory");
            if (head + 1 < PH) { KST(0, (head + 1) & 1) KST(1, (head + 1) & 1) KST(2, (head + 1) & 1) KST(3, (head + 1) & 1) KST(4, (head + 1) & 1) KST(5, (head + 1) & 1) KST(6, (head + 1) & 1) KST(7, (head + 1) & 1) }
            __syncthreads();
        }
    }
}


typedef short s16x4_t __attribute__((ext_vector_type(4)));
DI unsigned cvt_pk_bf16_f32(float lo, float hi) { unsigned r; asm("v_cvt_pk_bf16_f32 %0, %1, %2" : "=v"(r) : "v"(lo), "v"(hi)); return r; }
typedef __bf16 bf16x2n_t __attribute__((ext_vector_type(2)));
DI unsigned cvt_pk_safe(float lo, float hi) { const f32x2_t v = {lo, hi}; const bf16x2n_t b = __builtin_convertvector(v, bf16x2n_t); return __builtin_bit_cast(unsigned, b); }
DI s16x4_t lds_tr_read(const unsigned char* p) { return __builtin_bit_cast(s16x4_t, __builtin_amdgcn_ds_read_tr16_b64_v4i16((LAS s16x4_t*)p)); }
constexpr int S5_IMG = 32 * 72;
DI void ph_s5mfma(Frame& F) {
    const int lane = F.lane, cc = lane & 31, hh = lane >> 5;
    const float* lamp = (const float*)(F.a->ws + WS_LAM); const float* bbp = (const float*)(F.a->ws + WS_BB);
    const bf16_t* px = (const bf16_t*)(F.a->ws + WS_R2); const bf16_t* pc = (const bf16_t*)(F.a->ws + WS_PC);
    float* ytmp = (float*)(F.a->ws + WS_R1); bf16_t* gy = (bf16_t*)(F.a->ws + WS_GY);
    unsigned char* img = F.lds + F.wave * (4 * S5_IMG);
    const int asel = (cc >> 2) & 1, aoff = (cc & 3) + 4 * (cc >> 3);
    const int i16 = lane & 15, tq = i16 >> 2, tp = i16 & 3, blk = (lane >> 4) & 1;
    if (F.wave < 2) {
        for (int task = F.bid * 2 + F.wave; task < S5G * (NB / 2); task += F.G * 2) {
            const int g = task & 31, bp = task >> 5;
            const int bA = 2 * bp + asel;
            const int bD = 2 * bp + hh;
#pragma unroll 1
            for (int dr = 0; dr < 2; ++dr) {
                const int dg = dr * S5G + g;
                bf16x8_t Bf[4];
                float lr[2], li[2];
#pragma unroll
                for (int set = 0; set < 2; ++set) {
                    const int st = 32 * set + cc;
                    lr[set] = lamp[(dg * S5P + st) * 2]; li[set] = lamp[(dg * S5P + st) * 2 + 1];
#pragma unroll
                    for (int j = 0; j < 8; ++j) {
                        Bf[2 * set][j] = (short)f2bf(bbp[((size_t)(dg * S5P + st) * S5H + 8 * hh + j) * 2]);
                        Bf[2 * set + 1][j] = (short)f2bf(bbp[((size_t)(dg * S5P + st) * S5H + 8 * hh + j) * 2 + 1]);
                    }
                }
                bf16x8_t Cf[8];
#pragma unroll
                for (int T = 0; T < 4; ++T)
#pragma unroll
                    for (int sk = 0; sk < 2; ++sk)
#pragma unroll
                        for (int j = 0; j < 8; ++j) {
                            const int st = 32 * (T >> 1) + 16 * sk + 8 * hh + j;
                            float v = 0.f;
                            if (cc < S5H) v = (T & 1) ? -F.a->in[16][((size_t)dg * S5H + cc) * S5P + st] : F.a->in[15][((size_t)dg * S5H + cc) * S5P + st];
                            Cf[T * 2 + sk][j] = (short)f2bf(v);
                        }
                bf16x8_t Dg;
#pragma unroll
                for (int j = 0; j < 8; ++j) Dg[j] = (short)((cc == 8 * hh + j) ? f2bf(F.a->in[17][g * S5H + cc]) : (bf16_t)0);
                float sr[2] = {0.f, 0.f}, si[2] = {0.f, 0.f};
#pragma unroll 1
                for (int tt = 0; tt < LC / 16; ++tt) {
                    const int t0 = dr == 0 ? tt * 16 : LC - 16 - tt * 16;
                    const bf16x8_t uf = *(const bf16x8_t*)(pc + ((size_t)bA * LC + t0 + aoff) * S5W + g * S5H + 8 * hh);
                    f32x16_t z;
#pragma unroll
                    for (int i = 0; i < 16; ++i) z[i] = 0.f;
                    f32x16_t bu[4];
#pragma unroll
                    for (int T = 0; T < 4; ++T) bu[T] = __builtin_amdgcn_mfma_f32_32x32x16_bf16(uf, Bf[T], z, 0, 0, 0);
#pragma unroll
                    for (int ii = 0; ii < 16; ++ii) {
                        const int i = dr == 0 ? ii : 15 - ii;
#pragma unroll
                        for (int set = 0; set < 2; ++set) {
                            const float nr = lr[set] * sr[set] - li[set] * si[set] + bu[2 * set][i], ni = lr[set] * si[set] + li[set] * sr[set] + bu[2 * set + 1][i];
                            sr[set] = nr; si[set] = ni;
                        }
                    }
                }
#pragma unroll 1
                for (int tt = 0; tt < SEQ / 16; ++tt) {
                    const int t0 = dr == 0 ? tt * 16 : SEQ - 16 - tt * 16;
                    const bf16x8_t uf = *(const bf16x8_t*)(px + ((size_t)bA * SEQ + t0 + aoff) * PROJ + g * S5H + 8 * hh);
                    f32x16_t z;
#pragma unroll
                    for (int i = 0; i < 16; ++i) z[i] = 0.f;
                    f32x16_t bu[4];
#pragma unroll
                    for (int T = 0; T < 4; ++T) bu[T] = __builtin_amdgcn_mfma_f32_32x32x16_bf16(uf, Bf[T], z, 0, 0, 0);
#pragma unroll
                    for (int ii = 0; ii < 16; ++ii) {
                        const int i = dr == 0 ? ii : 15 - ii;
#pragma unroll
                        for (int set = 0; set < 2; ++set) {
                            const float nr = lr[set] * sr[set] - li[set] * si[set] + bu[2 * set][i], ni = lr[set] * si[set] + li[set] * sr[set] + bu[2 * set + 1][i];
                            sr[set] = nr; si[set] = ni; bu[2 * set][i] = nr; bu[2 * set + 1][i] = ni;
                        }
                    }
#pragma unroll
                    for (int T = 0; T < 4; ++T)
#pragma unroll
                        for (int gq = 0; gq < 4; ++gq) {
                            uint2 w; w.x = cvt_pk_bf16_f32(bu[T][4 * gq], bu[T][4 * gq + 1]); w.y = cvt_pk_bf16_f32(bu[T][4 * gq + 2], bu[T][4 * gq + 3]);
                            *(uint2*)(img + T * S5_IMG + cc * 72 + 8 * (2 * gq + hh)) = w;
                        }
                    asm volatile("s_waitcnt lgkmcnt(0)" ::: "memory");
                    f32x16_t y = z;
                    if (dr == 0) y = __builtin_amdgcn_mfma_f32_32x32x16_bf16(uf, Dg, y, 0, 0, 0);
#pragma unroll
                    for (int T = 0; T < 4; ++T)
#pragma unroll
                        for (int sk = 0; sk < 2; ++sk) {
                            const s16x4_t lo = lds_tr_read(img + T * S5_IMG + (16 * sk + 8 * hh + tq) * 72 + 8 * (4 * blk + tp));
                            const s16x4_t hi = lds_tr_read(img + T * S5_IMG + (16 * sk + 8 * hh + 4 + tq) * 72 + 8 * (4 * blk + tp));
                            const bf16x8_t xa = __builtin_shufflevector(lo, hi, 0, 1, 2, 3, 4, 5, 6, 7);
                            y = __builtin_amdgcn_mfma_f32_32x32x16_bf16(xa, Cf[T * 2 + sk], y, 0, 0, 0);
                        }
                    asm volatile("s_waitcnt lgkmcnt(0)" ::: "memory");
                    if (cc < S5H) {
                        const size_t o0 = ((size_t)bD * SEQ + t0) * S5W + g * S5H + cc;
                        if (dr == 0) {
#pragma unroll
                            for (int i = 0; i < 16; ++i) ytmp[o0 + (size_t)i * S5W] = y[i];
                        } else {
#pragma unroll
                            for (int i = 0; i < 16; ++i) gy[o0 + (size_t)i * S5W] = f2bf(gelu_f(ytmp[o0 + (size_t)i * S5W] + y[i]));
                        }
                    }
                }
            }
        }
    }
}


typedef unsigned u32x4_t __attribute__((ext_vector_type(4)));
constexpr int HZS = 4112;
DI void ph_hyena(Frame& F) {
    unsigned char* Zl = F.lds; unsigned char* GRl = F.lds + 32 * HZS;
    const int tid = F.tid, lane = F.lane, cb = lane & 31, hh = lane >> 5;
    const int T0 = F.wave * 256;
    const bf16_t* qc = (const bf16_t*)(F.a->ws + WS_R3);
    const bf16_t* GR = (const bf16_t*)(F.a->ws + WS_GR);
    bf16_t* z3 = (bf16_t*)(F.a->ws + WS_Z3);
    for (int c = F.bid; c < HYW; c += F.G) {
        __syncthreads();
        {
            const bf16_t* zs = qc + ((size_t)(tid >> 8) * HYC3 + c) * SEQ + (tid & 255) * 8; unsigned char* zd = Zl + (tid >> 8) * HZS + (tid & 255) * 16;
#define ZLD(p) const uint4 zr##p = *(const uint4*)(zs + (size_t)(2 * p) * HYC3 * SEQ);
#define ZST(p) *(uint4*)(zd + (2 * p) * HZS) = zr##p;
            ZLD(0) ZLD(1) ZLD(2) ZLD(3) ZLD(4) ZLD(5) ZLD(6) ZLD(7) ZLD(8) ZLD(9) ZLD(10) ZLD(11) ZLD(12) ZLD(13) ZLD(14) ZLD(15)
            ZST(0) ZST(1) ZST(2) ZST(3) ZST(4) ZST(5) ZST(6) ZST(7) ZST(8) ZST(9) ZST(10) ZST(11) ZST(12) ZST(13) ZST(14) ZST(15)
#undef ZLD
#undef ZST
        }
#pragma unroll
        for (int o = 0; o < 2; ++o) *(uint4*)(GRl + o * 8192 + tid * 16) = *(const uint4*)(GR + (size_t)(o * HYW + c) * 4096 + tid * 8);
        __syncthreads();
#pragma unroll 1
        for (int o = 0; o < 2; ++o) {
            f32x16_t acc[8];
#pragma unroll
            for (int a = 0; a < 8; ++a)
#pragma unroll
                for (int i = 0; i < 16; ++i) acc[a][i] = 0.f;
            const LAS u32x4_t* wp4 = (const LAS u32x4_t*)(LAS unsigned char*)(GRl + o * 8192 + 2 * (2040 - T0 - 8 * cb + 8 * hh));
            const LAS bf16x8_t* zp8 = (const LAS bf16x8_t*)(LAS unsigned char*)(Zl + cb * HZS + 16 * hh);
#define HY_STEP(W0, W1, BZ) { const unsigned w[8] = {W0.x, W0.y, W0.z, W0.w, W1.x, W1.y, W1.z, W1.w}; \
                _Pragma("unroll") for (int a = 0; a < 8; ++a) { const int e = a >> 1; u32x4_t f; \
                    if ((a & 1) == 0) { f.x = w[4 - e]; f.y = w[5 - e]; f.z = w[6 - e]; f.w = w[7 - e]; } \
                    else { f.x = __builtin_amdgcn_alignbit(w[4 - e], w[3 - e], 16); f.y = __builtin_amdgcn_alignbit(w[5 - e], w[4 - e], 16); f.z = __builtin_amdgcn_alignbit(w[6 - e], w[5 - e], 16); f.w = __builtin_amdgcn_alignbit(w[7 - e], w[6 - e], 16); } \
                    acc[a] = __builtin_amdgcn_mfma_f32_32x32x16_bf16(__builtin_bit_cast(bf16x8_t, f), BZ, acc[a], 0, 0, 0); } }
            u32x4_t wa0 = wp4[0], wa1 = wp4[1]; bf16x8_t bza = zp8[0];
            u32x4_t wb0, wb1; bf16x8_t bzb;
#pragma unroll 1
            for (int ks = 0; ks < SEQ / 16; ks += 2) {
                wb0 = wp4[2 * ks + 2]; wb1 = wp4[2 * ks + 3]; bzb = zp8[2 * ks + 2];
                __builtin_amdgcn_sched_barrier(0);
                HY_STEP(wa0, wa1, bza)
                __builtin_amdgcn_sched_barrier(0);
                if (ks + 2 < SEQ / 16) { wa0 = wp4[2 * ks + 4]; wa1 = wp4[2 * ks + 5]; bza = zp8[2 * ks + 4]; }
                __builtin_amdgcn_sched_barrier(0);
                HY_STEP(wb0, wb1, bzb)
                __builtin_amdgcn_sched_barrier(0);
            }
#undef HY_STEP
            const float dd = F.a->in[29][o * HYW + c];
            const int prow = tid >> 8, ppc = tid & 255;
            const unsigned goff = (unsigned)(((prow * HYC3 + (o + 1) * HYW + c) * SEQ + ppc * 8) * 2);
            const unsigned zoff = (unsigned)(((prow * HYW + c) * SEQ + ppc * 8) * 2);
            __syncthreads();
#pragma unroll
            for (int i = 0; i < 16; ++i) {
                const int t = T0 + 8 * ((i & 3) + 8 * (i >> 2) + 4 * hh);
                const uint4 zq = *(const uint4*)(Zl + cb * HZS + 2 * t);
                const unsigned zw[4] = {zq.x, zq.y, zq.z, zq.w};
                float r[8];
#pragma unroll
                for (int a = 0; a < 8; ++a) {
                    const float zv = (a & 1) ? __uint_as_float(zw[a >> 1] & 0xffff0000u) : __uint_as_float(zw[a >> 1] << 16);
                    r[a] = acc[a][i] + dd * zv;
                }
                uint4 ov; ov.x = cvt_pk_bf16_f32(r[0], r[1]); ov.y = cvt_pk_bf16_f32(r[2], r[3]); ov.z = cvt_pk_bf16_f32(r[4], r[5]); ov.w = cvt_pk_bf16_f32(r[6], r[7]);
                *(uint4*)(Zl + cb * HZS + 2 * t) = ov;
            }
            __builtin_amdgcn_sched_barrier(0);
            uint4 gqa[16];
#pragma unroll
            for (int p = 0; p < 16; ++p) gqa[p] = *(const uint4*)((const unsigned char*)qc + (goff + (unsigned)p * (unsigned)(2 * HYC3 * SEQ * 2)));
            __syncthreads();
#pragma unroll
            for (int p = 0; p < 16; ++p) {
                unsigned char* zp = Zl + (prow + 2 * p) * HZS + ppc * 16;
                const uint4 zq = *(const uint4*)zp; const uint4 gq = gqa[p];
                const unsigned gw[4] = {gq.x, gq.y, gq.z, gq.w}, zw[4] = {zq.x, zq.y, zq.z, zq.w};
                unsigned ow[4];
#pragma unroll
                for (int q = 0; q < 4; ++q) ow[q] = pk2(__uint_as_float(gw[q] << 16) * __uint_as_float(zw[q] << 16), __uint_as_float(gw[q] & 0xffff0000u) * __uint_as_float(zw[q] & 0xffff0000u));
                const uint4 ov = make_uint4(ow[0], ow[1], ow[2], ow[3]);
                if (o == 0) *(uint4*)zp = ov;
                else *(uint4*)((unsigned char*)z3 + (zoff + (unsigned)p * (unsigned)(2 * HYW * SEQ * 2))) = ov;
            }
            if (o == 0) __syncthreads();
        }
    }
}


DI void ph_s5tab(Frame& F) {
    uint4* tab = (uint4*)(F.a->ws + WS_S5T);
    for (int e = F.bid * NT + F.tid; e < 64 * 13 * 64; e += F.G * NT) {
        const int lane = e & 63, f = (e >> 6) % 13, dg = e / (13 * 64), g = dg & 31, cc = lane & 31, hh = lane >> 5;
        float v[8];
        if (f < 4) {
            const int set = f >> 1, st = 32 * set + cc;
            const float ar = F.a->in[10][dg * S5P + st], ai = F.a->in[11][dg * S5P + st];
            const float step = expf(F.a->in[12][dg]);
            const float mag = expf(ar * step);
            const float lr = mag * cosf(ai * step), li = mag * sinf(ai * step);
            const float nr = lr - 1.f, ni = li, den = ar * ar + ai * ai;
            const float fr = (nr * ar + ni * ai) / den, fi = (ni * ar - nr * ai) / den;
#pragma unroll
            for (int j = 0; j < 8; ++j) {
                const float br = F.a->in[13][(size_t)(dg * S5P + st) * S5H + 8 * hh + j], bi = F.a->in[14][(size_t)(dg * S5P + st) * S5H + 8 * hh + j];
                v[j] = (f & 1) ? fr * bi + fi * br : fr * br - fi * bi;
            }
        } else if (f < 12) {
            const int T = (f - 4) >> 1, sk = (f - 4) & 1;
#pragma unroll
            for (int j = 0; j < 8; ++j) {
                const int st = 32 * (T >> 1) + 16 * sk + 8 * hh + j;
                v[j] = cc < S5H ? ((T & 1) ? -F.a->in[16][((size_t)dg * S5H + cc) * S5P + st] : F.a->in[15][((size_t)dg * S5H + cc) * S5P + st]) : 0.f;
            }
        } else {
#pragma unroll
            for (int j = 0; j < 8; ++j) v[j] = (cc == 8 * hh + j) ? F.a->in[17][g * S5H + cc] : 0.f;
        }
        tab[e] = make_uint4(pk2(v[0], v[1]), pk2(v[2], v[3]), pk2(v[4], v[5]), pk2(v[6], v[7]));
    }
}

constexpr int S5CH = 128, S5NQ = 18;
DI void s5_consts_B(const float* lamp, const uint4* tab, int dg, int cc, int lane, bf16x8_t (&Bf)[4], float (&lr)[2], float (&li)[2]) {
    const uint4* tp = tab + (size_t)dg * (13 * 64) + lane;
#pragma unroll
    for (int T = 0; T < 4; ++T) Bf[T] = __builtin_bit_cast(bf16x8_t, tp[T * 64]);
#pragma unroll
    for (int set = 0; set < 2; ++set) { const float2 l2 = *(const float2*)(lamp + (dg * S5P + 32 * set + cc) * 2); lr[set] = l2.x; li[set] = l2.y; }
}
DI void s5_consts_C(const uint4* tab, int dg, int lane, bf16x8_t (&Cf)[8], bf16x8_t& Dg) {
    const uint4* tp = tab + (size_t)dg * (13 * 64) + lane;
#pragma unroll
    for (int T = 0; T < 8; ++T) Cf[T] = __builtin_bit_cast(bf16x8_t, tp[(4 + T) * 64]);
    Dg = __builtin_bit_cast(bf16x8_t, tp[12 * 64]);
}
DI void cpow128(float lr, float li, float& pr, float& pi) {
    pr = lr; pi = li;
#pragma unroll
    for (int k = 0; k < 7; ++k) { const float nr = pr * pr - pi * pi, ni = 2.f * pr * pi; pr = nr; pi = ni; }
}
template <int DR, bool WB>
DI void s5_tile_scan(const bf16x8_t uf, const bf16x8_t (&Bf)[4], const float (&lr)[2], const float (&li)[2], float (&sr)[2], float (&si)[2], f32x16_t (&bu)[4]) {
    f32x16_t z;
#pragma unroll
    for (int i = 0; i < 16; ++i) z[i] = 0.f;
#pragma unroll
    for (int T = 0; T < 4; ++T) bu[T] = __builtin_amdgcn_mfma_f32_32x32x16_bf16(uf, Bf[T], z, 0, 0, 0);
#pragma unroll
    for (int ii = 0; ii < 16; ++ii) {
        constexpr int dummy = 0; (void)dummy;
        const int i = DR == 0 ? ii : 15 - ii;
#pragma unroll
        for (int set = 0; set < 2; ++set) {
            const float nr = __builtin_fmaf(lr[set], sr[set], __builtin_fmaf(-li[set], si[set], bu[2 * set][i])), ni = __builtin_fmaf(lr[set], si[set], __builtin_fmaf(li[set], sr[set], bu[2 * set + 1][i]));
            sr[set] = nr; si[set] = ni;
            if (WB) { bu[2 * set][i] = nr; bu[2 * set + 1][i] = ni; }
        }
    }
}
template <int DR>
DI void s5_pass1_chunk(const bf16x8_t (&u)[8], const bf16x8_t (&Bf)[4], const float (&lr)[2], const float (&li)[2], float (&sr)[2], float (&si)[2]) {
#pragma unroll
    for (int tq = 0; tq < 8; ++tq) { f32x16_t bu[4]; s5_tile_scan<DR, false>(u[tq], Bf, lr, li, sr, si, bu); }
}
DI void ph_s5pass1(Frame& F) {
    const int lane = F.lane, cc = lane & 31, hh = lane >> 5;
    const float* lamp = (const float*)(F.a->ws + WS_LAM);
    const bf16_t* px = (const bf16_t*)(F.a->ws + WS_R2); const bf16_t* pc = (const bf16_t*)(F.a->ws + WS_PC);
    float* Lp = (float*)(F.a->ws + WS_L);
    const int asel = (cc >> 2) & 1, aoff = (cc & 3) + 4 * (cc >> 3);
    constexpr int NTASK = S5NQ * 64 * (NB / 2);
    const int tstride = F.G * NWV;
    bf16x8_t un[4];
#define P1_ADDR(T) const int q_ = (T) % S5NQ, rest_ = (T) / S5NQ, dg_ = rest_ & 63, bp_ = rest_ >> 6, dr_ = dg_ >> 5, g_ = dg_ & 31, bA_ = 2 * bp_ + asel; \
        const bf16_t* src_; size_t rs_; int base_; \
        if (q_ < 2) { const int ck = dr_ == 0 ? q_ : 1 - q_; base_ = ck * S5CH; src_ = pc + (size_t)bA_ * LC * S5W + g_ * S5H + 8 * hh; rs_ = S5W; } \
        else { const int ck = dr_ == 0 ? q_ - 2 : 17 - q_; base_ = ck * S5CH; src_ = px + (size_t)bA_ * SEQ * PROJ + g_ * S5H + 8 * hh; rs_ = PROJ; }
#define P1_FETCH(T) { P1_ADDR(T) _Pragma("unroll") for (int j = 0; j < 4; ++j) un[j] = *(const bf16x8_t*)(src_ + (size_t)(base_ + 16 * (dr_ ? 7 - j : j) + aoff) * rs_); }
    const bool split = (tstride * 9 == NTASK);
    const int ntk = split ? (F.wave < 4 ? 10 : 8) : (NTASK + tstride - 1) / tstride;
#define P1_TASK(tk_) ((split && (tk_) == 9) ? F.bid * NWV + F.wave + 4 + 8 * tstride : F.bid * NWV + F.wave + (tk_) * tstride)
    if (P1_TASK(0) < NTASK) P1_FETCH(P1_TASK(0))
#pragma unroll 1
    for (int tk = 0; tk < ntk; ++tk) {
        const int task = P1_TASK(tk);
        if (task >= NTASK) break;
        const int q = task % S5NQ, rest = task / S5NQ, dg = rest & 63, bp = rest >> 6, dr = dg >> 5, g = dg & 31;
        bf16x8_t u[8]; bf16x8_t Bf[4]; float lr[2], li[2];
        s5_consts_B(lamp, (const uint4*)(F.a->ws + WS_S5T), dg, cc, lane, Bf, lr, li);
#pragma unroll
        for (int j = 0; j < 4; ++j) u[j] = un[j];
        { P1_ADDR(task)
#pragma unroll
          for (int j = 4; j < 8; ++j) u[j] = *(const bf16x8_t*)(src_ + (size_t)(base_ + 16 * (dr_ ? 7 - j : j) + aoff) * rs_); }
        if (tk + 1 < ntk && P1_TASK(tk + 1) < NTASK) P1_FETCH(P1_TASK(tk + 1))
        float sr[2] = {0.f, 0.f}, si[2] = {0.f, 0.f};
        if (dr == 0) s5_pass1_chunk<0>(u, Bf, lr, li, sr, si);
        else s5_pass1_chunk<1>(u, Bf, lr, li, sr, si);
        float* lo = Lp + ((((size_t)(dr * S5NQ + q) * S5G + g) * NB + 2 * bp + hh) * S5P) * 2;
#pragma unroll
        for (int set = 0; set < 2; ++set) *(float2*)(lo + (32 * set + cc) * 2) = make_float2(sr[set], si[set]);
    }
#undef P1_TASK
#undef P1_FETCH
#undef P1_ADDR
}
template <int DR>
DI void s5_pass2_dir(Frame& F, const bf16_t* usrc, int g, int k, int bD, int cc, int hh, unsigned char* img, bf16_t* yl, bf16_t* gy,
                     const float* lamp, const float* bbp, const float* Lp) {
    const int lane = F.lane;
    const int i16 = lane & 15, tq = i16 >> 2, tp = i16 & 3, blk = (lane >> 4) & 1;
    const int dg = DR * S5G + g;
    bf16x8_t Bf[4]; float lr[2], li[2]; bf16x8_t Cf[8];
    s5_consts_B(lamp, (const uint4*)(F.a->ws + WS_S5T), dg, cc, lane, Bf, lr, li);
    float sr[2] = {0.f, 0.f}, si[2] = {0.f, 0.f};
    {
        float pr[2], pi[2];
        cpow128(lr[0], li[0], pr[0], pi[0]); cpow128(lr[1], li[1], pr[1], pi[1]);
        const int nq = DR == 0 ? k + 2 : 17 - k;
        const float* lq = Lp + ((((size_t)(DR * S5NQ) * S5G + g) * NB + bD) * S5P) * 2;
        float2 lv[17][2];
#pragma unroll
        for (int q = 0; q < 17; ++q)
#pragma unroll
            for (int set = 0; set < 2; ++set) lv[q][set] = (q < nq) ? *(const float2*)(lq + (size_t)q * (S5G * NB * S5P * 2) + (32 * set + cc) * 2) : make_float2(0.f, 0.f);
#pragma unroll
        for (int q = 0; q < 17; ++q)
#pragma unroll
            for (int set = 0; set < 2; ++set) {
                const float nr = pr[set] * sr[set] - pi[set] * si[set] + lv[q][set].x, ni = pr[set] * si[set] + pi[set] * sr[set] + lv[q][set].y;
                sr[set] = (q < nq) ? nr : sr[set]; si[set] = (q < nq) ? ni : si[set];
            }
    }
    asm volatile("" ::: "memory");
    bf16x8_t Dg;
    s5_consts_C((const uint4*)(F.a->ws + WS_S5T), dg, lane, Cf, Dg);
    const int base = k * S5CH;
    bf16x8_t ua = *(const bf16x8_t*)(usrc + (size_t)(16 * (DR == 0 ? 0 : 7)) * PROJ), ub = *(const bf16x8_t*)(usrc + (size_t)(16 * (DR == 0 ? 1 : 6)) * PROJ), uc = *(const bf16x8_t*)(usrc + (size_t)(16 * (DR == 0 ? 2 : 5)) * PROJ);
#pragma unroll
    for (int tn = 0; tn < 8; ++tn) {
        const int tt = DR == 0 ? tn : 7 - tn;
        const int tl0 = 16 * tt;
        const bf16x8_t ucur = ua; ua = ub; ub = uc;
        if (tn + 3 < 8) uc = *(const bf16x8_t*)(usrc + (size_t)(16 * (DR == 0 ? tn + 3 : 7 - (tn + 3))) * PROJ);
        f32x16_t bu[4];
        s5_tile_scan<DR, true>(ucur, Bf, lr, li, sr, si, bu);
#pragma unroll
        for (int T = 0; T < 4; ++T)
#pragma unroll
            for (int gq = 0; gq < 4; ++gq) {
                uint2 w; w.x = cvt_pk_bf16_f32(bu[T][4 * gq], bu[T][4 * gq + 1]); w.y = cvt_pk_bf16_f32(bu[T][4 * gq + 2], bu[T][4 * gq + 3]);
                *(uint2*)(img + T * 2048 + cc * 64 + 8 * ((2 * gq + hh) ^ ((cc >> 1) & 7))) = w;
            }
        asm volatile("s_waitcnt lgkmcnt(0)" ::: "memory");
        f32x16_t y;
#pragma unroll
        for (int i = 0; i < 16; ++i) y[i] = 0.f;
        if (DR == 0) y = __builtin_amdgcn_mfma_f32_32x32x16_bf16(ucur, Dg, y, 0, 0, 0);
#pragma unroll
        for (int T = 0; T < 4; ++T)
#pragma unroll
            for (int sk = 0; sk < 2; ++sk) {
                const int r0 = 16 * sk + 8 * hh + tq, r1 = r0 + 4;
                const s16x4_t lo = lds_tr_read(img + T * 2048 + r0 * 64 + 8 * ((4 * blk + tp) ^ ((r0 >> 1) & 7)));
                const s16x4_t hi = lds_tr_read(img + T * 2048 + r1 * 64 + 8 * ((4 * blk + tp) ^ ((r1 >> 1) & 7)));
                const bf16x8_t xa = __builtin_shufflevector(lo, hi, 0, 1, 2, 3, 4, 5, 6, 7);
                y = __builtin_amdgcn_mfma_f32_32x32x16_bf16(xa, Cf[T * 2 + sk], y, 0, 0, 0);
            }
        asm volatile("s_waitcnt lgkmcnt(0)" ::: "memory");
        {
            const int c16 = cc & 15, up = cc >> 4;
            float yv[8];
#pragma unroll
            for (int i = 0; i < 8; ++i) yv[i] = __uint_as_float(__builtin_amdgcn_permlane16_swap(__float_as_uint(y[i]), __float_as_uint(y[i + 8]), false, false)[0]);
            bf16_t* ylp = yl + ((size_t)(tl0 + 8 * up) * 2 + hh) * S5H + c16;
            if (DR == 0) {
#pragma unroll
                for (int i = 0; i < 8; ++i) ylp[i * 2 * S5H] = (bf16_t)cvt_pk_safe(yv[i], yv[i]);
            } else {
                bf16_t* gp = gy + ((size_t)bD * SEQ + base + tl0 + 8 * up) * S5W + g * S5H + c16;
#pragma unroll
                for (int i = 0; i < 8; ++i) { const float gv = gelu_fast(bf2f(ylp[i * 2 * S5H]) + yv[i]); gp[(size_t)i * S5W] = (bf16_t)cvt_pk_safe(gv, gv); }
            }
        }
        asm volatile("s_waitcnt lgkmcnt(0)" ::: "memory");
        __builtin_amdgcn_sched_barrier(0);
    }
}
DI void ph_s5pass2(Frame& F) {
    const int lane = F.lane, cc = lane & 31, hh = lane >> 5;
    const float* lamp = (const float*)(F.a->ws + WS_LAM); const float* bbp = (const float*)(F.a->ws + WS_BB);
    const bf16_t* px = (const bf16_t*)(F.a->ws + WS_R2);
    const float* Lp = (const float*)(F.a->ws + WS_L);
    bf16_t* gy = (bf16_t*)(F.a->ws + WS_GY);
    unsigned char* img = F.lds + F.wave * 8192;
    bf16_t* yl = (bf16_t*)(F.lds + 65536 + F.wave * 8192);
    const int asel = (cc >> 2) & 1, aoff = (cc & 3) + 4 * (cc >> 3);
    const bool split53 = (F.G * NWV * 4 == 16 * S5G * (NB / 2));
    const int ntk = split53 ? (F.wave < 4 ? 5 : 3) : 1 << 30;
#pragma unroll 1
    for (int tk = 0; tk < ntk; ++tk) {
        const int task = (split53 && tk == 4) ? F.bid * NWV + (F.wave + 4) + 3 * F.G * NWV : F.bid * NWV + F.wave + tk * F.G * NWV;
        if (task >= 16 * S5G * (NB / 2)) break;
        const int g = task & 31, k = (task >> 5) & 15, bp = task >> 9;
        const int bA = 2 * bp + asel, bD = 2 * bp + hh;
        const bf16_t* src = px + (size_t)bA * SEQ * PROJ + g * S5H + 8 * hh;
        const bf16_t* usrc = src + (size_t)(k * S5CH + aoff) * PROJ;
        s5_pass2_dir<0>(F, usrc, g, k, bD, cc, hh, img, yl, gy, lamp, bbp, Lp);
        s5_pass2_dir<1>(F, usrc, g, k, bD, cc, hh, img, yl, gy, lamp, bbp, Lp);
    }
}


template <bool VP>
DI void ph_tabprep4(Frame& F, int it_lo, int it_hi, int wg, int nwg) {
    const int lane = F.lane, sl = lane & 31, half = lane >> 5;
    float4 nx[8];
    if (it_lo + wg * NWV + F.wave >= it_hi) return;
    {   const int it = it_lo + wg * NWV + F.wave; const int tab = it >> 13, row = 2 * (it & 8191) + half;
        const float* src = (tab ? F.a->in[37] : F.a->in[36]) + (size_t)row * DM;
#pragma unroll
        for (int j = 0; j < 8; ++j) nx[j] = *(const float4*)(src + (256 * (j >> 1) + 8 * sl + 4 * (j & 1))); }
#pragma unroll 1
    for (int it = it_lo + wg * NWV + F.wave; it < it_hi; it += nwg * NWV) {
        const int tab = it >> 13, row = 2 * (it & 8191) + half;
        float x[32]; float ssq = 0.f, amax = 0.f;
#pragma unroll
        for (int j = 0; j < 8; ++j) { const float4 t = nx[j]; const int xo = VP ? 16 * (j & 1) + 4 * (j >> 1) : 4 * j; x[xo] = t.x; x[xo + 1] = t.y; x[xo + 2] = t.z; x[xo + 3] = t.w; }
        {   const int itn = it + nwg * NWV;
            if (itn < it_hi) { const int tabn = itn >> 13, rown = 2 * (itn & 8191) + half; const float* srcn = (tabn ? F.a->in[37] : F.a->in[36]) + (size_t)rown * DM;
#pragma unroll
                for (int j = 0; j < 8; ++j) nx[j] = *(const float4*)(srcn + (256 * (j >> 1) + 8 * sl + 4 * (j & 1))); } }
#pragma unroll
        for (int j = 0; j < 32; ++j) { ssq += x[j] * x[j]; amax = fmaxf(amax, fabsf(x[j])); }
        ssq = half_sum(ssq, lane); amax = half_max(amax, lane);
        float step = fmaxf(0.335f * sqrtf(ssq * (1.f / DM)), amax * (1.f / 12.f));
        if (!(step > 0.f)) step = 1.f;
        const float inv = 1.f / step;
        unsigned w[4];
#pragma unroll
        for (int i = 0; i < 4; ++i) {
            unsigned ww = 0u;
#pragma unroll
            for (int b = 0; b < 4; ++b) {
                const int lo = (int)fminf(fmaxf(rintf(x[8 * i + b] * inv), -8.f), 7.f) + 8, hi = (int)fminf(fmaxf(rintf(x[8 * i + 4 + b] * inv), -8.f), 7.f) + 8;
                ww |= tab ? (((unsigned)lo << (4 * b)) | ((unsigned)hi << (4 * b + 16))) : (((unsigned)(lo ^ 8) << (4 * b)) | ((unsigned)(hi ^ 8) << (4 * b + 16)));
            }
            w[i] = ww;
        }
        *(uint4*)(F.a->ws + (tab ? WS_V4 : WS_U4) + (size_t)row * 512 + sl * 16) = make_uint4(w[0], w[1], w[2], w[3]);
        if (sl == 0) ((float*)(F.a->ws + WS_SU))[2 * row + tab] = step;
    }
}

DI float reduce8h(const float (&v)[8], int lane) {
    const bool b4 = (lane & 16) != 0, b3 = (lane & 8) != 0, b2 = (lane & 4) != 0;
    float a[4], b[2];
#pragma unroll
    for (int j = 0; j < 4; ++j) { const float send = b4 ? v[j] : v[j + 4], keep = b4 ? v[j + 4] : v[j]; a[j] = keep + __shfl_xor(send, 16); }
#pragma unroll
    for (int j = 0; j < 2; ++j) { const float send = b3 ? a[j] : a[j + 2], keep = b3 ? a[j + 2] : a[j]; b[j] = keep + __shfl_xor(send, 8); }
    const float send = b2 ? b[0] : b[1], keep = b2 ? b[1] : b[0];
    float x = keep + __shfl_xor(send, 4);
    x += __shfl_xor(x, 1); x += __shfl_xor(x, 2);
    return x;
}
DI void ph_gather4(Frame& F) {
    const int lane = F.lane, sl = lane & 31, half = lane >> 5;
    const float2* suv = (const float2*)(F.a->ws + WS_SU);
    const int* tke = (const int*)(F.a->ws + WS_R3); const float* tkg = (const float*)(F.a->ws + WS_TKG);
    const bf16_t* hx2 = (const bf16_t*)(F.a->ws + WS_R1);
    const int jj = lane & 15, srcl = ((jj & 1) << 5) | (((jj >> 3) & 1) << 4) | (((jj >> 2) & 1) << 3) | (((jj >> 1) & 1) << 2);
    int* lew = (int*)(F.lds + F.wave * 512);
    const int* le = lew + half;
    const unsigned char* u4_base = F.a->ws + WS_U4; const unsigned char* v4_base = F.a->ws + WS_V4; const unsigned sl16 = (unsigned)sl * 16u;
#define G4_LOAD(buf, tab, h64_, bb_) _Pragma("unroll") for (int kk = 0; kk < 8; ++kk) { const int e = le[(h64_) * 64 + (bb_) * 16 + 2 * kk]; buf[kk] = *(const uint4*)(tab##_base + ((unsigned)e * 512u + sl16)); }
#define G4_U(buf, h64_, bb_) { float part[8]; _Pragma("unroll") for (int kk = 0; kk < 8; ++kk) { const unsigned w[4] = {buf[kk].x, buf[kk].y, buf[kk].z, buf[kk].w}; int dh = 0, dl = 0; \
        _Pragma("unroll") for (int i = 0; i < 4; ++i) { dh = __builtin_amdgcn_sdot8((int)w[i], Hhi[i], dh, false); dl = __builtin_amdgcn_sdot8((int)w[i], Hlo[i], dl, false); } part[kk] = (float)(16 * dh + dl); } \
        const float t2 = __shfl(reduce8h(part, lane), srcl); const float c = gvv[h64_] * gelu_fast(t2 * sue[h64_]) * sve[h64_]; cv[h64_] = ((lane >> 4) == (bb_)) ? c : cv[h64_]; }
#define G4_V(buf, h64_, bb_) _Pragma("unroll") for (int kk = 0; kk < 8; ++kk) { \
        const _Float16 c1 = lc[(h64_) * 64 + (bb_) * 16 + 2 * kk]; csum += (float)c1; const h2_t ch = {c1, c1}; const h2_t ch16 = ch * (h2_t){(_Float16)0.0625f, (_Float16)0.0625f}; \
        const unsigned w[4] = {buf[kk].x, buf[kk].y, buf[kk].z, buf[kk].w}; \
        _Pragma("unroll") for (int i = 0; i < 4; ++i) { const unsigned wh = w[i] >> 8; \
            acch[4 * i + 0] += ch * __builtin_bit_cast(h2_t, w[i] & 0x000F000Fu); acch[4 * i + 1] += ch16 * __builtin_bit_cast(h2_t, w[i] & 0x00F000F0u); \
            acch[4 * i + 2] += ch * __builtin_bit_cast(h2_t, wh & 0x000F000Fu); acch[4 * i + 3] += ch16 * __builtin_bit_cast(h2_t, wh & 0x00F000F0u); } }
    LAS int* cnt = (LAS int*)(LAS unsigned char*)(F.lds + 4096 + 65536);
    const int NPW = NTOK / F.G;
    _Float16* lcw = (_Float16*)(F.lds + 4096);
    for (int base = 0; base < NPW; base += 256) {
    const int nsl = NPW - base < 256 ? NPW - base : 256;
    if (F.tid == 0) { cnt[0] = 0; cnt[1] = 0; }
    __syncthreads();
    for (;;) {
        int slot = 0;
        if (lane == 0) slot = __hip_atomic_fetch_add(cnt, 1, __ATOMIC_RELAXED, __HIP_MEMORY_SCOPE_WORKGROUP);
        slot = __builtin_amdgcn_readfirstlane(slot);
        if (slot >= nsl) break;
        const int toki = F.bid * NWV + ((base + slot) & 7) + ((base + slot) >> 3) * (F.G * NWV);
        const size_t tok = toki;
        int Hhi[4], Hlo[4]; float hscale;
        {
            float hv[32]; float hm = 0.f;
#pragma unroll
            for (int q4 = 0; q4 < 4; ++q4) {
                const uint4 a = *(const uint4*)(hx2 + tok * DM + 256 * q4 + 8 * sl);
                const unsigned w[4] = {a.x, a.y, a.z, a.w};
#pragma unroll
                for (int i = 0; i < 4; ++i) { hv[q4 * 8 + 2 * i] = __uint_as_float(w[i] << 16); hv[q4 * 8 + 2 * i + 1] = __uint_as_float(w[i] & 0xffff0000u); }
            }
#pragma unroll
            for (int j = 0; j < 32; ++j) hm = fmaxf(hm, fabsf(hv[j]));
            hm = half_max(hm, lane);
            hscale = hm > 0.f ? hm * (1.f / 119.f) : 1.f;
            const float hinv = 1.f / hscale;
#pragma unroll
            for (int i = 0; i < 4; ++i) {
                unsigned whi = 0u, wlo = 0u;
#pragma unroll
                for (int p = 0; p < 8; ++p) { const int q = (int)rintf(hv[8 * i + p] * hinv); const int lo = ((q + 8) & 15) - 8, hi = (q - lo) >> 4; wlo |= ((unsigned)lo & 15u) << (4 * p); whi |= ((unsigned)hi & 15u) << (4 * p); }
                Hhi[i] = (int)whi; Hlo[i] = (int)wlo;
            }
        }
        int ev[2]; float cv[2];
        uint4 bufA[8], bufB[8], bufC[8];
        ev[0] = tke[tok * 128 + lane]; ev[1] = tke[tok * 128 + 64 + lane];
        lew[lane] = ev[0]; lew[64 + lane] = ev[1];
        float gvv[2], sue[2], sve[2];
#pragma unroll
        for (int h64 = 0; h64 < 2; ++h64) { gvv[h64] = tkg[tok * 128 + h64 * 64 + lane]; const float2 st2 = suv[ev[h64]]; sue[h64] = st2.x * hscale; sve[h64] = st2.y; }
        cv[0] = 0.f; cv[1] = 0.f;
        G4_LOAD(bufA, u4, 0, 0) G4_LOAD(bufB, u4, 0, 1) __builtin_amdgcn_sched_barrier(0);
        G4_LOAD(bufC, u4, 0, 2) G4_U(bufA, 0, 0) __builtin_amdgcn_sched_barrier(0);
        G4_LOAD(bufA, u4, 0, 3) G4_U(bufB, 0, 1) __builtin_amdgcn_sched_barrier(0);
        G4_LOAD(bufB, u4, 1, 0) G4_U(bufC, 0, 2) __builtin_amdgcn_sched_barrier(0);
        G4_LOAD(bufC, u4, 1, 1) G4_U(bufA, 0, 3) __builtin_amdgcn_sched_barrier(0);
        G4_LOAD(bufA, u4, 1, 2) G4_U(bufB, 1, 0) __builtin_amdgcn_sched_barrier(0);
        G4_LOAD(bufB, u4, 1, 3) G4_U(bufC, 1, 1) __builtin_amdgcn_sched_barrier(0);
        G4_U(bufA, 1, 2) __builtin_amdgcn_sched_barrier(0);
        G4_U(bufB, 1, 3) __builtin_amdgcn_sched_barrier(0);
        lcw[slot * 128 + lane] = (_Float16)fminf(fmaxf(cv[0] * 16384.f, -60000.f), 60000.f); lcw[slot * 128 + 64 + lane] = (_Float16)fminf(fmaxf(cv[1] * 16384.f, -60000.f), 60000.f);
        asm volatile("s_waitcnt lgkmcnt(0)" ::: "memory");
    }
    __syncthreads();
    for (;;) {
        int slot = 0;
        if (lane == 0) slot = __hip_atomic_fetch_add(cnt + 1, 1, __ATOMIC_RELAXED, __HIP_MEMORY_SCOPE_WORKGROUP);
        slot = __builtin_amdgcn_readfirstlane(slot);
        if (slot >= nsl) break;
        const int toki = F.bid * NWV + ((base + slot) & 7) + ((base + slot) >> 3) * (F.G * NWV);
        const size_t tok = toki; const int b = toki / SEQ;
        const _Float16* lc = lcw + slot * 128 + half;
        uint4 bufA[8], bufB[8], bufC[8];
        lew[lane] = tke[tok * 128 + lane]; lew[64 + lane] = tke[tok * 128 + 64 + lane];
        float csum = 0.f;
        h2_t acch[16];
#pragma unroll
        for (int j = 0; j < 16; ++j) acch[j] = (h2_t){(_Float16)0.f, (_Float16)0.f};
        G4_LOAD(bufA, v4, 0, 0) G4_LOAD(bufB, v4, 0, 1) __builtin_amdgcn_sched_barrier(0);
        G4_LOAD(bufC, v4, 0, 2) G4_V(bufA, 0, 0) __builtin_amdgcn_sched_barrier(0);
        G4_LOAD(bufA, v4, 0, 3) G4_V(bufB, 0, 1) __builtin_amdgcn_sched_barrier(0);
        G4_LOAD(bufB, v4, 1, 0) G4_V(bufC, 0, 2) __builtin_amdgcn_sched_barrier(0);
        G4_LOAD(bufC, v4, 1, 1) G4_V(bufA, 0, 3) __builtin_amdgcn_sched_barrier(0);
        G4_LOAD(bufA, v4, 1, 2) G4_V(bufB, 1, 0) __builtin_amdgcn_sched_barrier(0);
        G4_LOAD(bufB, v4, 1, 3) G4_V(bufC, 1, 1) __builtin_amdgcn_sched_barrier(0);
        G4_V(bufA, 1, 2) __builtin_amdgcn_sched_barrier(0);
        G4_V(bufB, 1, 3) __builtin_amdgcn_sched_barrier(0);
        const float csb = csum * (8.f / 16384.f);
        float accf[16];
#pragma unroll
        for (int ii = 0; ii < 2; ++ii)
#pragma unroll
            for (int sq = 0; sq < 4; ++sq) {
                const float a0 = (float)acch[4 * ii + sq].x * 1024.f - csb, a1 = (float)acch[4 * ii + sq].y * 1024.f - csb, b0 = (float)acch[4 * (ii + 2) + sq].x * 1024.f - csb, b1 = (float)acch[4 * (ii + 2) + sq].y * 1024.f - csb;
                const float ta0 = a0 + __shfl_xor(a0, 32), ta1 = a1 + __shfl_xor(a1, 32), tb0 = b0 + __shfl_xor(b0, 32), tb1 = b1 + __shfl_xor(b1, 32);
                accf[8 * ii + sq] = half ? tb0 : ta0; accf[8 * ii + sq + 4] = half ? tb1 : ta1;
            }
        const int eoff = 8 * sl + 4 * half;
        const float* g2 = (const float*)(F.a->ws + WS_MOD) + (size_t)b * (6 * DM) + 5 * DM + eoff;
        float* xr = F.a->out + tok * DM + eoff;
        const float* gf = F.a->in[38] + eoff;
        float x1f[16];
        {
            const bf16_t* xb = (const bf16_t*)(F.a->ws + WS_X1B) + tok * DM + eoff;
#pragma unroll
            for (int j = 0; j < 4; ++j) { const uint2 xa = *(const uint2*)(xb + 256 * j);
                x1f[4 * j] = __uint_as_float(xa.x << 16); x1f[4 * j + 1] = __uint_as_float(xa.x & 0xffff0000u); x1f[4 * j + 2] = __uint_as_float(xa.y << 16); x1f[4 * j + 3] = __uint_as_float(xa.y & 0xffff0000u); }
        }
        float xv[16]; float ss = 0.f;
#pragma unroll
        for (int j = 0; j < 4; ++j) {
            const float4 x4 = make_float4(x1f[4 * j], x1f[4 * j + 1], x1f[4 * j + 2], x1f[4 * j + 3]), g4 = *(const float4*)(g2 + 256 * j);
            xv[4 * j] = x4.x + g4.x * accf[4 * j]; xv[4 * j + 1] = x4.y + g4.y * accf[4 * j + 1]; xv[4 * j + 2] = x4.z + g4.z * accf[4 * j + 2]; xv[4 * j + 3] = x4.w + g4.w * accf[4 * j + 3];
            ss += xv[4 * j] * xv[4 * j] + xv[4 * j + 1] * xv[4 * j + 1] + xv[4 * j + 2] * xv[4 * j + 2] + xv[4 * j + 3] * xv[4 * j + 3];
        }
        ss = wave_sum(ss);
        const float rstd = rsqrtf(ss * (1.f / DM) + EPSF);
#pragma unroll
        for (int j = 0; j < 4; ++j) {
            const float4 f4 = *(const float4*)(gf + 256 * j);
            float4 o; o.x = xv[4 * j] * rstd * f4.x; o.y = xv[4 * j + 1] * rstd * f4.y; o.z = xv[4 * j + 2] * rstd * f4.z; o.w = xv[4 * j + 3] * rstd * f4.w;
            { const f32x4_t ov4 = {o.x, o.y, o.z, o.w}; __builtin_nontemporal_store(ov4, (f32x4_t*)(xr + 256 * j)); }
        }
    }
    __syncthreads();
    }
#undef G4_LOAD
#undef G4_U
#undef G4_V
}

constexpr int N_PHASES = 12;
#ifndef REP_MASK
#define REP_MASK 0u
#endif
__global__ void __launch_bounds__(NT, 2) fwd_megakernel(Args args) {
    extern __shared__ __attribute__((aligned(16))) unsigned char lds[];
    Frame F;
    F.lds = lds;
    F.tid = threadIdx.x; F.lane = F.tid & 63; F.wave = __builtin_amdgcn_readfirstlane(F.tid >> 6); F.G = gridDim.x; F.bid = blockIdx.x;
    F.a = &args;
    unsigned char* ws = args.ws;
    LAS unsigned char* ldsL = (LAS unsigned char*)lds;

    volatile LAS unsigned* MISC = (volatile LAS unsigned*)((LAS unsigned char*)lds + MISC_OFF);
    if (F.tid < 64) MISC[F.tid] = 0u;
    __syncthreads();
    const int lo = args.ph_lo, hi = args.ph_hi;
    const bool multi = (hi - lo) > 1;
    XcdBarrier bar; bar.bar = (unsigned*)(ws + WS_CTL); bar.x = 0; bar.st = nullptr;
    if (multi) bar = xcd_barrier_post((unsigned*)(ws + WS_CTL), MISC + 8);
#define IN(k) (lo <= (k) && (k) < hi)
#define REPS(k) for (int rep_ = 0; rep_ < (int)((REP_MASK >> (k)) & 1u) + 1; ++rep_, __syncthreads())
#define SEAM(k) do { if (IN(k) && IN((k) + 1)) xcd_barrier(bar); } while (0)

    if (IN(0)) ph_mod(F);
    SEAM(0);
    if (IN(1)) {
        if (F.bid & 1) {
            ph_normmod(F, (F.a->in[0]), (F.a->in[2]), NTOK + NCTX, (F.a->in[6]), 0, 1, ((bf16_t*)(F.a->ws + WS_R1)));
            ph_s5prep(F); __syncthreads(); ph_filt_mlp(F); __syncthreads(); ph_wprep(F); ph_tabprep4<false>(F, 0, 8192, F.bid, F.G); ph_keyprep(F); ph_s5tab(F);
        } else {
            ph_s5prep(F); __syncthreads(); ph_filt_mlp(F); __syncthreads(); ph_wprep(F); ph_tabprep4<false>(F, 0, 8192, F.bid, F.G); ph_keyprep(F); ph_s5tab(F);
            ph_normmod(F, (F.a->in[0]), (F.a->in[2]), NTOK + NCTX, (F.a->in[6]), 0, 1, ((bf16_t*)(F.a->ws + WS_R1)));
        }
    }
    SEAM(1);
    if (IN(2)) {
        pg8::Gemm g{(const bf16_t*)(ws + WS_R1), (const bf16_t*)(ws + WS_WINT), NTOK + NCTX, PROJ, DM}; pg8::OrderPx S; S.init(F.G, F.bid);
        pg8::EpiPxB E{(bf16_t*)(ws + WS_R2), (bf16_t*)(ws + WS_PC), args.in[9]};
        const int skip0 = F.G > 64 ? 64 : 0;
        const bool tail_first = (F.bid >= skip0) && (F.bid & 1) && (F.G > 64);
        if (tail_first) { ph_filt_fin(F, F.bid - skip0, F.G - skip0); ph_tabprep4<true>(F, 8192, 16384, F.bid - skip0, F.G - skip0); __syncthreads(); }
        pg8::gemm_phase<pg8::EpiPxB, pg8::OrderPx, true, true>(ldsL, g, S, E);
        const int skip = F.G > 64 ? 64 : 0;
        if (F.bid >= skip && !tail_first) { __syncthreads(); ph_filt_fin(F, F.bid - skip, F.G - skip); ph_tabprep4<true>(F, 8192, 16384, F.bid - skip, F.G - skip); }
    }
    SEAM(2);
    if (IN(3)) { if (F.bid & 1) { ph_shortconv(F); ph_s5pass1(F); } else { ph_s5pass1(F); ph_shortconv(F); } }
    SEAM(3);
    if (IN(4)) { ph_s5pass2(F); ph_hyena(F); }
    SEAM(4);
    const bool own57 = (F.G * 256 == NTOK) && IN(5) && IN(6) && IN(7);
    if (IN(5)) {
        const bool hy_first = own57 && (F.bid & 1);
        if (hy_first) { ph_cat_hy(F, 4 * F.bid, 4 * F.bid + 4, 1); __syncthreads(); }
        { pg8::Gemm g{(const bf16_t*)(ws + WS_GY), (const bf16_t*)(ws + WS_WGLUT), NTOK, S5W, S5W}; pg8::OrderRowPair S; S.init(F.G, F.bid);
          pg8::EpiGluB E{(bf16_t*)(ws + WS_S5O), (const bf16_t*)(ws + WS_GY), args.in[19]};
          pg8::gemm_phase<pg8::EpiGluB, pg8::OrderRowPair, true, true>(ldsL, g, S, E); }
        __syncthreads();
        for (int rb = F.bid; rb < NTOK / 256; rb += F.G) ph_cat_s5(F, rb * 256, rb * 256 + 256);
        __syncthreads();
        if (own57) { if (!hy_first) ph_cat_hy(F, 4 * F.bid, 4 * F.bid + 4, 1); }
        else ph_cat_hy(F, F.bid, (SEQ / 64) * NB, F.G);
    }
    if (own57) { __syncthreads(); __builtin_amdgcn_fence(__ATOMIC_ACQUIRE, "agent"); } else { SEAM(5); SEAM(6); }
    if (IN(7)) {
        pg8::Gemm g{(const bf16_t*)(ws + WS_R1), (const bf16_t*)(ws + WS_WOUTT), NTOK, DM, DM}; pg8::OrderRowQuad S; S.init(F.G, F.bid);
        pg8::EpiResB E{(bf16_t*)(ws + WS_X1B), args.in[0], (const float*)(ws + WS_MOD) + 2 * DM};
        pg8::gemm_phase<pg8::EpiResB, pg8::OrderRowQuad, true, true>(ldsL, g, S, E);
        __syncthreads(); __builtin_amdgcn_fence(__ATOMIC_ACQUIRE, "agent");
        for (int rb = F.bid; rb < NTOK / 256; rb += F.G) ph_normmod_b(F, (const bf16_t*)(F.a->ws + WS_X1B), (F.a->in[7]), 3, 4, ((bf16_t*)(F.a->ws + WS_R1)), rb * 256, rb * 256 + 256);
    }
    SEAM(8);
    if (IN(9)) {
        pg8::Gemm g{(const bf16_t*)(ws + WS_R1), (const bf16_t*)(ws + WS_WQT), NTOK, PROJ, DM}; pg8::StaticOrder S; S.init(NTOK, PROJ, F.G, F.bid);
        pg8::EpiQB E{(bf16_t*)(ws + WS_R2)};
        pg8::gemm_phase<pg8::EpiQB, pg8::StaticOrder, true, true>(ldsL, g, S, E);
    }
    SEAM(9);
    if (IN(10)) ph_topk2(F);
    SEAM(10);
    if (IN(11)) ph_gather4(F);
#undef IN
#undef SEAM
}

#ifndef MK_PER_PHASE
#define MK_PER_PHASE 0
#endif
extern "C" void kernel_launch(void* const* d_in, const int* in_sizes, int n_in, void* d_out, int out_size, void* d_ws, size_t ws_size, hipStream_t stream) {
    static int grid = 0;
    if (grid == 0) {
        int dev = 0, cus = 0, per_cu = 0;
        if (hipGetDevice(&dev) != hipSuccess || hipDeviceGetAttribute(&cus, hipDeviceAttributeMultiprocessorCount, dev) != hipSuccess) { fprintf(stderr, "kernel_launch: device query failed\n"); grid = -1; return; }
        if (hipFuncSetAttribute((const void*)fwd_megakernel, hipFuncAttributeMaxDynamicSharedMemorySize, LDS_BYTES) != hipSuccess) { fprintf(stderr, "kernel_launch: hipFuncSetAttribute failed\n"); grid = -1; return; }
        if (hipOccupancyMaxActiveBlocksPerMultiprocessor(&per_cu, (const void*)fwd_megakernel, NT, LDS_BYTES) != hipSuccess || per_cu < 1) { fprintf(stderr, "kernel_launch: occupancy query says %d blocks per CU\n", per_cu); }
        (void)hipGetLastError();
        grid = cus;
    }
    if (grid < 0) return;
    (void)hipMemsetAsync((char*)d_ws + WS_CTL, 0, CTL_ZERO_BYTES, stream);
    Args a{};
    for (int i = 0; i < 39; ++i) a.in[i] = (const float*)d_in[i];
    a.out = (float*)d_out; a.ws = (unsigned char*)d_ws;
#if MK_PER_PHASE
    for (int p = 0; p < N_PHASES; ++p) { a.ph_lo = p; a.ph_hi = p + 1; hipLaunchKernelGGL(fwd_megakernel, dim3(grid), dim3(NT), LDS_BYTES, stream, a); }
#else
    a.ph_lo = 0; a.ph_hi = N_PHASES;
    hipLaunchKernelGGL(fwd_megakernel, dim3(grid), dim3(NT), LDS_BYTES, stream, a);
#endif
}
```
